# Optimizing an MI355X kernel written in HIP

```python
import jax, jax.numpy as jnp
from jax import lax
import numpy as np

D_MODEL = 1024
BATCH = 16
SEQ = 2048
DEPTH = 4
DEC_BATCH = 1
DEC_SEQ = 16384
PAST_LEN = 128

N_MIXERS = 3
GRID_W = 64
NORM_EPS = 1e-6
CHUNK = 128
A_WIDTH = 3 * D_MODEL
A_GROUPS = 8
A_GROUP_DIM = A_WIDTH // A_GROUPS
HEAD_DIM = 128
N_HEADS = D_MODEL // HEAD_DIM
N_KV_HEADS = 2
Q_PER_KV = N_HEADS // N_KV_HEADS
AXIS_DIM = HEAD_DIM // 2
ROPE_THETA = 10000.0
Q_BLOCK = 128
C_GROUPS = 8
C_GROUP_DIM = D_MODEL // C_GROUPS
D_FF = 4 * D_MODEL

kernel_name = "hybrid_interleaved_gmlp_gqa_fnet_encoder"


def rms_norm(x, g):
    xf = x.astype(jnp.float32)
    y = xf * lax.rsqrt(jnp.mean(xf * xf, axis=-1, keepdims=True) + NORM_EPS)
    return (y * g.astype(jnp.float32)).astype(x.dtype)


def gmlp_mixer(h, w_in, v_norm, w_s, b_s, w_out):
    b, s, _ = h.shape
    z = jax.nn.gelu(h @ w_in, approximate=False)
    u, v = jnp.split(z, 2, axis=-1)
    v = rms_norm(v, v_norm)
    v = v.reshape(b, s // CHUNK, CHUNK, A_GROUPS, A_GROUP_DIM)
    sv = jnp.einsum('gpq,bcqgd->bcpgd', w_s, v) + b_s.T[:, :, None]
    return (u * sv.reshape(b, s, A_WIDTH)) @ w_out


def rope_section(xs, ang):
    x1, x2 = jnp.split(xs.astype(jnp.float32), 2, axis=-1)
    cos = jnp.cos(ang)[None, :, None, :]
    sin = jnp.sin(ang)[None, :, None, :]
    return jnp.concatenate([x1 * cos - x2 * sin, x1 * sin + x2 * cos], axis=-1)


def axial_rope(x, ang_row, ang_col):
    out = jnp.concatenate([rope_section(x[..., :AXIS_DIM], ang_row),
                           rope_section(x[..., AXIS_DIM:], ang_col)], axis=-1)
    return out.astype(x.dtype)


def gqa_mixer(h, w_qkv, q_norm, k_norm, w_o, ang_row, ang_col):
    b, s, _ = h.shape
    qkv = h @ w_qkv
    q = qkv[..., :N_HEADS * HEAD_DIM].reshape(b, s, N_HEADS, HEAD_DIM)
    k = qkv[..., N_HEADS * HEAD_DIM:(N_HEADS + N_KV_HEADS) * HEAD_DIM].reshape(b, s, N_KV_HEADS, HEAD_DIM)
    v = qkv[..., (N_HEADS + N_KV_HEADS) * HEAD_DIM:].reshape(b, s, N_KV_HEADS, HEAD_DIM)
    q = axial_rope(rms_norm(q, q_norm), ang_row, ang_col)
    k = axial_rope(rms_norm(k, k_norm), ang_row, ang_col)
    scale = HEAD_DIM ** -0.5
    k = k.transpose(0, 2, 1, 3)
    v = v.transpose(0, 2, 1, 3)
    nb = s // Q_BLOCK
    qb = q.reshape(b, nb, Q_BLOCK, N_KV_HEADS, Q_PER_KV, HEAD_DIM).transpose(1, 0, 3, 4, 2, 5)

    def block(qblk):
        sc = jnp.einsum('bkgqd,bksd->bkgqs', qblk, k).astype(jnp.float32) * scale
        p = jax.nn.softmax(sc, axis=-1)
        return jnp.einsum('bkgqs,bksd->bkgqd', p.astype(v.dtype), v)

    o = lax.map(block, qb)
    o = o.transpose(1, 0, 4, 2, 3, 5).reshape(b, s, N_HEADS * HEAD_DIM)
    return o @ w_o


def fnet_mixer(h, w_out):
    b, s, _ = h.shape
    hg = h.astype(jnp.float32).reshape(b, s, C_GROUPS, C_GROUP_DIM)
    f = jnp.fft.fftn(hg, axes=(1, 3), norm='ortho').real
    return f.astype(h.dtype).reshape(b, s, D_MODEL) @ w_out


def sq_relu_mlp(h, w_in, w_out):
    return jnp.square(jax.nn.relu(h @ w_in)) @ w_out


def trunk(x, norm_gains, a_w_in, a_v_norm, a_w_s, a_b_s, a_w_out,
          b_w_qkv, b_q_norm, b_k_norm, b_w_o, c_w_out, mlp_w_in, mlp_w_out):
    s = x.shape[1]
    rows = s // GRID_W
    row_pos = jnp.repeat(jnp.arange(rows, dtype=jnp.float32), GRID_W)
    col_pos = jnp.tile(jnp.arange(GRID_W, dtype=jnp.float32), rows)
    inv_freq = ROPE_THETA ** (-jnp.arange(0, AXIS_DIM, 2, dtype=jnp.float32) / AXIS_DIM)
    ang_row = row_pos[:, None] * inv_freq[None, :]
    ang_col = col_pos[:, None] * inv_freq[None, :]
    for i in range(DEPTH):
        m, j = i % N_MIXERS, i // N_MIXERS
        g = norm_gains[i]
        h = rms_norm(x, g[0])
        if m == 0:
            y = gmlp_mixer(h, a_w_in[j], a_v_norm[j], a_w_s[j], a_b_s[j], a_w_out[j])
        elif m == 1:
            y = gqa_mixer(h, b_w_qkv[j], b_q_norm[j], b_k_norm[j], b_w_o[j], ang_row, ang_col)
        else:
            y = fnet_mixer(h, c_w_out[j])
        x = x + rms_norm(y, g[1])
        h = rms_norm(x, g[2])
        x = x + rms_norm(sq_relu_mlp(h, mlp_w_in[i], mlp_w_out[i]), g[3])
    return x


def setup_inputs(seed: int = 0) -> dict:
    key = jax.random.key(seed)
    ks = jax.random.split(key, 16)
    n_a = (DEPTH + 2) // 3
    n_b = (DEPTH + 1) // 3
    n_c = DEPTH // 3
    nrm = lambda k, shape, fan_in: jax.random.normal(k, shape, jnp.float32) * fan_in ** -0.5
    qkv_out = (N_HEADS + 2 * N_KV_HEADS) * HEAD_DIM
    return {
        "x_prompt": jax.random.normal(ks[0], (BATCH, SEQ, D_MODEL), jnp.float32),
        "x_sample": jax.random.normal(ks[1], (DEC_BATCH, DEC_SEQ, D_MODEL), jnp.float32),
        "norm_gains": 1.0 + 0.02 * jax.random.normal(ks[2], (DEPTH, 4, D_MODEL), jnp.float32),
        "a_w_in": nrm(ks[3], (n_a, D_MODEL, 2 * A_WIDTH), D_MODEL),
        "a_v_norm": 1.0 + 0.02 * jax.random.normal(ks[4], (n_a, A_WIDTH), jnp.float32),
        "a_w_s": nrm(ks[5], (n_a, A_GROUPS, CHUNK, CHUNK), CHUNK),
        "a_b_s": 1.0 + 0.02 * jax.random.normal(ks[6], (n_a, A_GROUPS, CHUNK), jnp.float32),
        "a_w_out": nrm(ks[7], (n_a, A_WIDTH, D_MODEL), A_WIDTH),
        "b_w_qkv": nrm(ks[8], (n_b, D_MODEL, qkv_out), D_MODEL),
        "b_q_norm": 1.0 + 0.02 * jax.random.normal(ks[9], (n_b, HEAD_DIM), jnp.float32),
        "b_k_norm": 1.0 + 0.02 * jax.random.normal(ks[10], (n_b, HEAD_DIM), jnp.float32),
        "b_w_o": nrm(ks[11], (n_b, N_HEADS * HEAD_DIM, D_MODEL), N_HEADS * HEAD_DIM),
        "c_w_out": nrm(ks[12], (n_c, D_MODEL, D_MODEL), D_MODEL),
        "mlp_w_in": nrm(ks[13], (DEPTH, D_MODEL, D_FF), D_MODEL),
        "mlp_w_out": nrm(ks[14], (DEPTH, D_FF, D_MODEL), D_FF),
    }


def reference(x_prompt, x_sample, norm_gains, a_w_in, a_v_norm, a_w_s, a_b_s, a_w_out,
              b_w_qkv, b_q_norm, b_k_norm, b_w_o, c_w_out, mlp_w_in, mlp_w_out):
    y_prompt = trunk(x_prompt, norm_gains, a_w_in, a_v_norm, a_w_s, a_b_s, a_w_out,
                     b_w_qkv, b_q_norm, b_k_norm, b_w_o, c_w_out, mlp_w_in, mlp_w_out)
    y_sample = trunk(x_sample, norm_gains, a_w_in, a_v_norm, a_w_s, a_b_s, a_w_out,
                     b_w_qkv, b_q_norm, b_k_norm, b_w_o, c_w_out, mlp_w_in, mlp_w_out)
    return (y_prompt, y_sample)
```

```cpp
#include <hip/hip_runtime.h>
#include <hip/hip_cooperative_groups.h>
#include <cstdio>
#include <cstdint>
namespace cg = cooperative_groups;

#define LAS __attribute__((address_space(3)))
#define GAS __attribute__((address_space(1)))
typedef unsigned short bf16_t;
typedef short bf16x8 __attribute__((ext_vector_type(8)));
typedef short s16x4 __attribute__((ext_vector_type(4)));
typedef float f32x4 __attribute__((ext_vector_type(4)));
typedef float f32x2 __attribute__((ext_vector_type(2)));
typedef float f32x16 __attribute__((ext_vector_type(16)));
typedef unsigned u32x4 __attribute__((ext_vector_type(4)));
typedef unsigned u32x2 __attribute__((ext_vector_type(2)));

constexpr int DM = 1024, NTOK = 49152, NPROMPT = 32768, NSAMPLE = 16384, SEQP = 2048, SLAB = 16384;
constexpr int AW = 3072, DFF = 4096, QKVW = 1536;
constexpr float EPS = 1e-6f;
constexpr size_t MiB = 1u << 20;
constexpr size_t WS_SUMSQ = 0;
constexpr size_t WS_WS = 1 * MiB;
constexpr size_t WS_G = 2 * MiB;
constexpr size_t WS_T1 = 3 * MiB;
constexpr size_t WS_T3 = 3 * MiB + 256 * 1024;
constexpr size_t WS_DP = 4 * MiB;
constexpr size_t WS_WMIX = 20 * MiB;
constexpr size_t WS_WMIX2_A = WS_WMIX + 12 * MiB;
constexpr size_t WS_WMIX2_B = WS_WMIX + 4 * MiB;
constexpr size_t WS_WMI = 40 * MiB, WS_WMO = 48 * MiB;
constexpr size_t WS_H = 56 * MiB;
constexpr size_t WS_Y = 152 * MiB;
constexpr size_t WS_BIG = 248 * MiB;
constexpr size_t WS_PART = 504 * MiB;
constexpr size_t WS_END = 509 * MiB;
constexpr size_t WS_RS = 65536;
constexpr int LDS_BYTES = 147456;

__device__ __forceinline__ unsigned f2bf(float f) { unsigned u = __builtin_bit_cast(unsigned, f); return (u + 0x7fffu + ((u >> 16) & 1u)) >> 16; }
__device__ __forceinline__ unsigned pk2(float lo, float hi) { return f2bf(lo) | (f2bf(hi) << 16); }
__device__ __forceinline__ unsigned cvt_pk_bf16(float lo, float hi) { unsigned r; asm volatile("v_cvt_pk_bf16_f32 %0, %1, %2" : "=v"(r) : "v"(lo), "v"(hi)); return r; }
__device__ __forceinline__ float bf_lo(unsigned u) { return __builtin_bit_cast(float, u << 16); }
__device__ __forceinline__ float bf_hi(unsigned u) { return __builtin_bit_cast(float, u & 0xffff0000u); }
__device__ __forceinline__ float wave_sum(float v) {
#pragma unroll
    for (int o = 1; o < 64; o <<= 1) v += __shfl_xor(v, o);
    return v;
}
#define LDS_WAIT() asm volatile("s_waitcnt lgkmcnt(0)" ::: "memory")

namespace pg8 {
constexpr int BM = 256, BK = 64, HALF = 128, HTB = HALF * BK * 2, NXCD = 8, WGM = 8;
__device__ __forceinline__ int lds_byte(int r, int c) { const int st = (r >> 4) * 2 + (c >> 5), rr = r & 15, cc = c & 31, ob = rr * 64 + cc * 2; return st * 1024 + (ob ^ (((ob >> 9) & 1) << 5)); }
__device__ __forceinline__ void stage_rc(int b, int& R, int& C) { const int st = b / 1024, sb = b % 1024, swz = sb ^ (((sb >> 9) & 1) << 5); R = (st >> 1) * 16 + swz / 64; C = (st & 1) * 32 + (swz % 64) / 2; }
__device__ __forceinline__ int perm32(int rho) { const int n = rho >> 4, i = rho & 15; return 8 * (i >> 2) + 4 * n + (i & 3); }

struct Unit { size_t aoff, boff, coff; };
struct Desc {
    const char* A; const char* B; unsigned lda, ldb; unsigned ahs, bhs; int nt, kmask, kshift; unsigned kpA, kpB;
    int nM, nN, nZ; unsigned a_z, a_m, b_z, b_m, b_n; unsigned c_z, c_m, c_n;
    bf16_t* C; unsigned ldc; int mode; float* aux;
    const float* rsc; const float* csc; int cperm;
};
__device__ __forceinline__ bool next_unit(const Desc& d, int i, int G, int c, Unit& u) {
    const int per = d.nM * d.nN, nwg = per * d.nZ; const long L = (long)i * G + c; if (L >= nwg) return false;
    int wgid = (int)L; { const int q = nwg / NXCD, r = nwg % NXCD, xcd = wgid % NXCD, off = wgid / NXCD; wgid = (xcd < r ? xcd * (q + 1) : r * (q + 1) + (xcd - r) * q) + off; }
    const int z = wgid / per, w = wgid - z * per;
    const int nig = WGM * d.nN, gid = w / nig, fm = gid * WGM, gsz = (d.nM - fm) < WGM ? (d.nM - fm) : WGM;
    const int pm = fm + ((w % nig) % gsz), pn = (w % nig) / gsz;
    u.aoff = (size_t)z * d.a_z + (size_t)pm * d.a_m;
    u.boff = (size_t)z * d.b_z + (size_t)pm * d.b_m + (size_t)pn * d.b_n;
    u.coff = (size_t)z * d.c_z + (size_t)pm * d.c_m + (size_t)pn * d.c_n;
    return true;
}
__device__ __forceinline__ f32x2 gelu_pk(f32x2 v) {
    const f32x2 av = __builtin_elementwise_abs(v), d = av * 0.2316418882f + 1.0f;
    f32x2 t; t.x = __builtin_amdgcn_rcpf(d.x); t.y = __builtin_amdgcn_rcpf(d.y);
    f32x2 q = t * 0.5307027145f + (-0.7265760135f); q = q * t + 0.7107068705f; q = q * t + (-0.142248368f); q = q * t + 0.127414796f; q = q * t;
    const f32x2 s = (v * v) * (-0.72134752044f);
    f32x2 e; e.x = __builtin_amdgcn_exp2f(s.x); e.y = __builtin_amdgcn_exp2f(s.y);
    const f32x2 m = v * (q * e), r = v - m;
    f32x2 o; o.x = v.x < 0.f ? m.x : r.x; o.y = v.y < 0.f ? m.y : r.y; return o;
}
__device__ __forceinline__ f32x4 gelu4(f32x4 v) { f32x2 a = gelu_pk((f32x2){v[0], v[1]}), b = gelu_pk((f32x2){v[2], v[3]}); return (f32x4){a.x, a.y, b.x, b.y}; }
__device__ __forceinline__ u32x4 pack8(f32x4 v0, f32x4 v1) { u32x4 w; w.x = cvt_pk_bf16(v0[0], v0[1]); w.y = cvt_pk_bf16(v0[2], v0[3]); w.z = cvt_pk_bf16(v1[0], v1[1]); w.w = cvt_pk_bf16(v1[2], v1[3]); return w; }

__device__ __forceinline__ void load_scales(float (&rr)[2][4], f32x4 (&cv)[2][2], const Desc& d, const Unit& u, int wr, int wc, int fr_, int fq_) {
    int fr = fr_, fq = fq_; asm volatile("" : "+v"(fr), "+v"(fq));
    const unsigned ldc = d.ldc;
    const float* rp = d.rsc + (u.coff / ldc) + wr * 64 + fr;
#pragma unroll
    for (int ai = 0; ai < 2; ++ai)
#pragma unroll
        for (int m = 0; m < 4; ++m) rr[ai][m] = d.rsc ? rp[ai * HALF + m * 16] : 1.0f;
    const int cb = (int)(u.coff % ldc) + wc * 32 + 8 * fq;
#pragma unroll
    for (int bj = 0; bj < 2; ++bj)
#pragma unroll
        for (int n = 0; n < 2; ++n) {
            f32x4 c1 = {1.f, 1.f, 1.f, 1.f};
            if (d.csc) {
                if (d.cperm) {
#pragma unroll
                    for (int j = 0; j < 4; ++j) { const int nn = cb + bj * HALF + 4 * n + j; c1[j] = d.csc[128 * (nn & 127) + (nn >> 7)]; }
                } else c1 = *(const f32x4*)(d.csc + cb + bj * HALF + 4 * n);
            }
            cv[bj][n] = c1;
        }
}
__device__ __forceinline__ void epilogue(f32x4 (&acc)[2][2][4][2], const Desc& d, const Unit& u, int wr, int wc, int fr_, int fq_, const float (&rr)[2][4], const f32x4 (&cv)[2][2]) {
    int fr = fr_, fq = fq_; asm volatile("" : "+v"(fr), "+v"(fq));
    const unsigned ldc = d.ldc;
    bf16_t* base = d.C + u.coff + (size_t)(wr * 64 + fr) * ldc + wc * 32 + 8 * fq;
    const int mode = d.mode & 7;
    if (mode == 4) {
#pragma unroll
        for (int m = 0; m < 4; ++m) {
            const int k1 = wr * 64 + m * 16 + fr;
            float tc[8], ts[8];
#pragma unroll
            for (int e = 0; e < 8; ++e) { const int s2 = wc * 32 + 8 * fq + e; const float tr = (float)((k1 * s2) & 16383) * (1.0f / 16384.0f); tc[e] = __builtin_amdgcn_cosf(tr); ts[e] = __builtin_amdgcn_sinf(tr); }
            bf16_t* r0 = base + (size_t)(m * 16) * ldc; bf16_t* r1 = r0 + (size_t)HALF * ldc;
#pragma unroll
            for (int bj = 0; bj < 2; ++bj) {
                f32x4 yr0 = acc[0][bj][m][0], yr1 = acc[0][bj][m][1], yi0 = acc[1][bj][m][0], yi1 = acc[1][bj][m][1], a0, a1, b0, b1;
#pragma unroll
                for (int j = 0; j < 4; ++j) { a0[j] = yr0[j] * tc[j] + yi0[j] * ts[j]; b0[j] = yi0[j] * tc[j] - yr0[j] * ts[j];
                                              a1[j] = yr1[j] * tc[4 + j] + yi1[j] * ts[4 + j]; b1[j] = yi1[j] * tc[4 + j] - yr1[j] * ts[4 + j]; }
                *(u32x4*)(r0 + bj * HALF) = pack8(a0, a1); *(u32x4*)(r1 + bj * HALF) = pack8(b0, b1);
            }
        }
        return;
    }
    float cs[2][2][4];
    if (mode == 3) {
#pragma unroll
        for (int bj = 0; bj < 2; ++bj)
#pragma unroll
            for (int n = 0; n < 2; ++n)
#pragma unroll
                for (int j = 0; j < 4; ++j) cs[bj][n][j] = 0.f;
    }
#pragma unroll
    for (int ai = 0; ai < 2; ++ai) {
        if (mode == 5 && ai == 1) break;
#pragma unroll
        for (int m = 0; m < 4; ++m) {
            bf16_t* rowp = base + (size_t)(ai * HALF + m * 16) * ldc;
#pragma unroll
            for (int bj = 0; bj < 2; ++bj) {
                f32x4 v0 = acc[ai][bj][m][0] * (cv[bj][0] * rr[ai][m]), v1 = acc[ai][bj][m][1] * (cv[bj][1] * rr[ai][m]);
                if (mode == 1 || mode == 3) { v0 = gelu4(v0); v1 = gelu4(v1); }
                if (mode == 2) {
#pragma unroll
                    for (int j = 0; j < 4; ++j) { const float a = fmaxf(v0[j], 0.f), b = fmaxf(v1[j], 0.f); v0[j] = a * a; v1[j] = b * b; }
                }
                if (mode == 3) {
#pragma unroll
                    for (int j = 0; j < 4; ++j) { cs[bj][0][j] += v0[j] * v0[j]; cs[bj][1][j] += v1[j] * v1[j]; }
                }
                if (!(d.mode & 8) || v0[0] == 12345.678f) *(u32x4*)(rowp + bj * HALF) = pack8(v0, v1);
            }
        }
    }
    if (mode == 3) {
        float* sq = d.aux + (size_t)((u.coff / ldc) / 256 * 2 + wr) * NTOK + (u.coff % ldc) + wc * 32 + 8 * fq;
#pragma unroll
        for (int bj = 0; bj < 2; ++bj)
#pragma unroll
            for (int n = 0; n < 2; ++n)
#pragma unroll
                for (int j = 0; j < 4; ++j) {
                    float s = cs[bj][n][j];
                    s += __shfl_xor(s, 1); s += __shfl_xor(s, 2); s += __shfl_xor(s, 4); s += __shfl_xor(s, 8);
                    if (fr == 0) sq[bj * HALF + 4 * n + j] = s;
                }
    }
}

__device__ __forceinline__ void gemm_phase(LAS unsigned char* lds, const Desc& g, int G, int c) {
    int tid = threadIdx.x; asm volatile("" : "+v"(tid));
    const int wid = __builtin_amdgcn_readfirstlane(tid >> 6), lane = tid & 63, wr = wid >> 2, wc = wid & 3, fr = lane & 15, fq = lane >> 4;
    const int nt = g.nt, kmask = g.kmask, kshift = g.kshift; const unsigned kpA = g.kpA, kpB = g.kpB;
    unsigned voffA[2], voffB[2];
#pragma unroll
    for (int i = 0; i < 2; ++i) { int R, C; stage_rc(tid * 16 + i * 8192, R, C); const int Rb = (R & ~31) + perm32(R & 31);
        voffA[i] = (unsigned)(R * g.lda + C) * 2u; voffB[i] = (unsigned)(Rb * g.ldb + C) * 2u; }
    const unsigned ahs = g.ahs, bhs = g.bhs;
    const unsigned ldsw = (unsigned)wid * 1024u;
    const int aoff = lds_byte(wr * 64 + fr, fq * 8), boff = lds_byte(wc * 32 + fr, fq * 8);
#define KOA(t) ((size_t)((t) & kmask) * 128u + (size_t)((t) >> kshift) * kpA)
#define KOB(t) ((size_t)((t) & kmask) * 128u + (size_t)((t) >> kshift) * kpB)
#define PG8_SA(b, h) (((b) * 2 + (h)) * HTB)
#define PG8_SB(b, h) ((4 + (b) * 2 + (h)) * HTB)
#define PG8_STAGE(bufoff, gbase, voff) do { _Pragma("unroll") for (int _i = 0; _i < 2; ++_i) \
        __builtin_amdgcn_global_load_lds((const unsigned*)((const char*)(gbase) + (voff)[_i]), (LAS unsigned*)(lds + (bufoff) + ldsw + _i * 8192), 16, 0, 0); } while (0)
#define PG8_LDA(dst, b, h) do { _Pragma("unroll") for (int m = 0; m < 4; ++m) _Pragma("unroll") for (int k = 0; k < 2; ++k) dst[m][k] = *(const LAS bf16x8*)(lds + PG8_SA(b, h) + aoff + m * 2048 + k * 1024); } while (0)
#define PG8_LDB(dst, b, h) do { _Pragma("unroll") for (int n = 0; n < 2; ++n) _Pragma("unroll") for (int k = 0; k < 2; ++k) dst[n][k] = *(const LAS bf16x8*)(lds + PG8_SB(b, h) + boff + n * 2048 + k * 1024); } while (0)
#define PG8_MMA(ai, bj, At, Bt) do { __builtin_amdgcn_s_setprio(1); _Pragma("unroll") for (int m = 0; m < 4; ++m) _Pragma("unroll") for (int n = 0; n < 2; ++n) _Pragma("unroll") for (int k = 0; k < 2; ++k) \
        acc[ai][bj][m][n] = __builtin_amdgcn_mfma_f32_16x16x32_bf16(Bt[n][k], At[m][k], acc[ai][bj][m][n], 0, 0, 0); __builtin_amdgcn_s_setprio(0); } while (0)
#define PG8_WAIT_V(n) asm volatile("s_waitcnt vmcnt(" #n ")" ::: "memory")
#define PG8_WAIT_L(n) asm volatile("s_waitcnt lgkmcnt(" #n ")" ::: "memory")
#define PG8_BAR __builtin_amdgcn_s_barrier()
#define PG8_SCHED __builtin_amdgcn_sched_barrier(0)
    Unit cur, nxt; int ui = 0;
    if (!next_unit(g, 0, G, c, cur)) return;
    f32x4 acc[2][2][4][2];
#pragma unroll
    for (int a = 0; a < 2; ++a)
#pragma unroll
        for (int b = 0; b < 2; ++b)
#pragma unroll
            for (int m = 0; m < 4; ++m)
#pragma unroll
                for (int n = 0; n < 2; ++n) acc[a][b][m][n] = (f32x4){0.f, 0.f, 0.f, 0.f};
    bf16x8 At[4][2], B0[2][2], B1[2][2];
    const char* cA = g.A + cur.aoff; const char* cB = g.B + cur.boff;
    {
        const size_t k1a = KOA(1), k1b = KOB(1);
        PG8_STAGE(PG8_SB(0, 0), cB, voffB); PG8_STAGE(PG8_SB(0, 1), cB + bhs, voffB); PG8_STAGE(PG8_SA(0, 0), cA, voffA); PG8_STAGE(PG8_SA(0, 1), cA + ahs, voffA);
        if (wr == 1) PG8_BAR;
        PG8_WAIT_V(2); PG8_BAR;
        PG8_STAGE(PG8_SB(1, 0), cB + k1b, voffB); PG8_STAGE(PG8_SA(1, 0), cA + k1a, voffA); PG8_STAGE(PG8_SB(1, 1), cB + bhs + k1b, voffB);
        PG8_WAIT_V(6); PG8_BAR;
    }
    float rr[2][4]; f32x4 cv[2][2];
    for (;;) {
        const bool has_next = next_unit(g, ui + 1, G, c, nxt);
        load_scales(rr, cv, g, cur, wr, wc, fr, fq);
        const char* nA = has_next ? g.A + nxt.aoff : cA; const char* nB = has_next ? g.B + nxt.boff : cB;
        for (int t = 0; t < nt; t += 2) {
            const bool last = (t == nt - 2);
            const char* a1 = cA + KOA(t + 1);
            const char* a2 = last ? nA : cA + KOA(t + 2); const char* b2 = last ? nB : cB + KOB(t + 2);
            const char* a3 = last ? nA + KOA(1) : cA + KOA(t + 3); const char* b3 = last ? nB + KOB(1) : cB + KOB(t + 3);
            PG8_LDB(B0, 0, 0); PG8_LDB(B1, 0, 1); PG8_SCHED; PG8_LDA(At, 0, 0); PG8_STAGE(PG8_SA(1, 1), a1 + ahs, voffA);
            PG8_WAIT_V(8); PG8_WAIT_L(0); PG8_BAR; PG8_MMA(0, 0, At, B0); PG8_MMA(0, 1, At, B1); PG8_BAR; PG8_SCHED;
            PG8_LDA(At, 0, 1); PG8_STAGE(PG8_SB(0, 0), b2, voffB); PG8_STAGE(PG8_SB(0, 1), b2 + bhs, voffB); PG8_STAGE(PG8_SA(0, 0), a2, voffA);
            PG8_WAIT_V(8); PG8_WAIT_L(0); PG8_BAR; PG8_MMA(1, 0, At, B0); PG8_MMA(1, 1, At, B1); PG8_BAR; PG8_SCHED;
            PG8_LDB(B0, 1, 0); PG8_LDB(B1, 1, 1); PG8_SCHED; PG8_LDA(At, 1, 0); PG8_STAGE(PG8_SA(0, 1), a2 + ahs, voffA);
            PG8_WAIT_V(8); PG8_WAIT_L(0); PG8_BAR; PG8_MMA(0, 0, At, B0); PG8_MMA(0, 1, At, B1); PG8_BAR; PG8_SCHED;
            PG8_LDA(At, 1, 1); PG8_STAGE(PG8_SB(1, 0), b3, voffB); PG8_STAGE(PG8_SB(1, 1), b3 + bhs, voffB); PG8_STAGE(PG8_SA(1, 0), a3, voffA);
            PG8_WAIT_V(8); PG8_WAIT_L(0); PG8_BAR; PG8_MMA(1, 0, At, B0); PG8_MMA(1, 1, At, B1); PG8_BAR; PG8_SCHED;
        }
        if (wr == 0) PG8_BAR;
        epilogue(acc, g, cur, wr, wc, fr, fq, rr, cv);
        if (!has_next) break;
#pragma unroll
        for (int a = 0; a < 2; ++a)
#pragma unroll
            for (int b = 0; b < 2; ++b)
#pragma unroll
                for (int m = 0; m < 4; ++m)
#pragma unroll
                    for (int n = 0; n < 2; ++n) acc[a][b][m][n] = (f32x4){0.f, 0.f, 0.f, 0.f};
        cur = nxt; cA = nA; cB = nB; ++ui;
        if (wr == 1) PG8_BAR;
    }
    PG8_WAIT_V(0);
    PG8_BAR;
#undef KOA
#undef KOB
#undef PG8_SA
#undef PG8_SB
#undef PG8_STAGE
#undef PG8_LDA
#undef PG8_LDB
#undef PG8_MMA
#undef PG8_WAIT_V
#undef PG8_WAIT_L
#undef PG8_BAR
#undef PG8_SCHED
}
}

namespace att {
constexpr int D = 128, NW = 8, QBLK = 32, KVBLK = 64;
constexpr float SCALE = 0.088388347648318440f;
constexpr float THR = 8.f;
constexpr int LDQ = QKVW, LDK = QKVW, LDO = DM;
constexpr size_t SHM_V = KVBLK * D * 2, SHM_K = KVBLK * D * 2;
#define KSWZ(row, colB) ((row) * 256 + ((colB) ^ (((row) & 7) << 4)))
#define SBAR() __builtin_amdgcn_sched_barrier(0)
__device__ __forceinline__ int crow(int r, int hi) { return (r & 3) + 8 * (r >> 2) + 4 * hi; }
__device__ __forceinline__ unsigned cvtpk(float lo, float hi) { unsigned r; asm volatile("v_cvt_pk_bf16_f32 %0, %1, %2" : "=v"(r) : "v"(lo), "v"(hi)); return r; }
__device__ __forceinline__ void partialSM(f32x16& p0, f32x16& p1, float& m_reg, float& mn, float& alpha) {
    constexpr float C = SCALE * 1.4426950408889634f;
    float pmax = p0[0];
#pragma unroll
    for (int r = 1; r < 16; ++r) pmax = fmaxf(pmax, p0[r]);
#pragma unroll
    for (int r = 0; r < 16; ++r) pmax = fmaxf(pmax, p1[r]);
    { auto rr = __builtin_amdgcn_permlane32_swap(__float_as_uint(pmax), __float_as_uint(pmax), false, false);
      pmax = fmaxf(__uint_as_float(rr[0]), __uint_as_float(rr[1])); }
    if (__builtin_expect(__all(pmax - m_reg <= THR / SCALE), 1)) { mn = m_reg; alpha = 1.f; }
    else { mn = fmaxf(m_reg, pmax); alpha = __builtin_amdgcn_exp2f((m_reg - mn) * C); m_reg = mn; }
    float mnC = -mn * C;
#pragma unroll
    for (int r = 0; r < 16; ++r) p0[r] = fmaf(p0[r], C, mnC);
#pragma unroll
    for (int r = 0; r < 16; ++r) p1[r] = fmaf(p1[r], C, mnC);
#pragma unroll
    for (int r = 0; r < 16; ++r) p0[r] = __builtin_amdgcn_exp2f(p0[r]);
}
__device__ __forceinline__ void finishSM(f32x16& p0, f32x16& p1, float alpha, float& l_reg, bf16x8& pa0, bf16x8& pa1, bf16x8& pa2, bf16x8& pa3) {
#pragma unroll
    for (int r = 0; r < 16; ++r) p1[r] = __builtin_amdgcn_exp2f(p1[r]);
    float ps = 0;
#pragma unroll
    for (int r = 0; r < 16; ++r) ps += p0[r];
#pragma unroll
    for (int r = 0; r < 16; ++r) ps += p1[r];
    { auto rr = __builtin_amdgcn_permlane32_swap(__float_as_uint(ps), __float_as_uint(ps), false, false);
      ps = __uint_as_float(rr[0]) + __uint_as_float(rr[1]); }
    l_reg = l_reg * alpha + ps;
#define PK4(P, BASE, OUT) do { unsigned a0 = cvtpk(P[BASE + 0], P[BASE + 1]), a1 = cvtpk(P[BASE + 2], P[BASE + 3]);   \
    unsigned b0 = cvtpk(P[BASE + 4], P[BASE + 5]), b1 = cvtpk(P[BASE + 6], P[BASE + 7]);                              \
    auto r0 = __builtin_amdgcn_permlane32_swap(a0, b0, false, false); auto r1 = __builtin_amdgcn_permlane32_swap(a1, b1, false, false); \
    u32x4 w = {r0[0], r1[0], r0[1], r1[1]}; OUT = *reinterpret_cast<bf16x8*>(&w); } while (0)
    PK4(p0, 0, pa0); PK4(p0, 8, pa1); PK4(p1, 0, pa2); PK4(p1, 8, pa3);
#undef PK4
}
__device__ __forceinline__ void qkt(f32x16& p0, f32x16& p1, const bf16_t* Ks, const bf16x8* qr, int r32, int hi) {
    p0 = f32x16{}; p1 = f32x16{};
#pragma unroll
    for (int d0 = 0; d0 < 8; ++d0) { int cb = (d0 * 16 + hi * 8) * 2;
        bf16x8 b0 = *reinterpret_cast<const bf16x8*>((const char*)Ks + KSWZ(r32, cb));
        bf16x8 b1 = *reinterpret_cast<const bf16x8*>((const char*)Ks + KSWZ(32 + r32, cb));
        p0 = __builtin_amdgcn_mfma_f32_32x32x16_bf16(b0, qr[d0], p0, 0, 0, 0);
        p1 = __builtin_amdgcn_mfma_f32_32x32x16_bf16(b1, qr[d0], p1, 0, 0, 0); }
}
__device__ __forceinline__ int v_st(int k, int c) { const int kk = (k & ~0xC) | ((k & 4) << 1) | ((k & 8) >> 1); return ((kk >> 3) * 4 + (c >> 5)) * 512 + ((kk & 7) * 32 + (c & 31)) * 2; }
__device__ __forceinline__ int v_rd_base(int lane) { return ((lane & 3) << 3) | (((lane >> 2) & 3) << 6) | (((lane >> 4) & 1) << 5) | (((lane >> 5) & 1) << 8); }
constexpr int v_rd_off(int d0, int ks, int half) { return d0 * 512 + ks * 4096 + half * 2048; }
template <int OFF> __device__ __forceinline__ s16x4 tr_read(int vb) {
    s16x4 r; asm volatile("ds_read_b64_tr_b16 %0, %1 offset:%2" : "=&v"(r) : "v"(vb), "i"(OFF) : "memory"); return r;
}
template <int D0> __device__ __forceinline__ void pv_one(f32x16& od, int vb, bf16x8 pa0, bf16x8 pa1, bf16x8 pa2, bf16x8 pa3) {
    const s16x4 l0 = tr_read<v_rd_off(D0, 0, 0)>(vb), h0 = tr_read<v_rd_off(D0, 0, 1)>(vb), l1 = tr_read<v_rd_off(D0, 1, 0)>(vb), h1 = tr_read<v_rd_off(D0, 1, 1)>(vb);
    const s16x4 l2 = tr_read<v_rd_off(D0, 2, 0)>(vb), h2 = tr_read<v_rd_off(D0, 2, 1)>(vb), l3 = tr_read<v_rd_off(D0, 3, 0)>(vb), h3 = tr_read<v_rd_off(D0, 3, 1)>(vb);
    asm volatile("s_waitcnt lgkmcnt(0)" ::: "memory"); SBAR();
#define PK(L, H) (bf16x8){L[0], L[1], L[2], L[3], H[0], H[1], H[2], H[3]}
    od = __builtin_amdgcn_mfma_f32_32x32x16_bf16(pa0, PK(l0, h0), od, 0, 0, 0);
    od = __builtin_amdgcn_mfma_f32_32x32x16_bf16(pa1, PK(l1, h1), od, 0, 0, 0);
    od = __builtin_amdgcn_mfma_f32_32x32x16_bf16(pa2, PK(l2, h2), od, 0, 0, 0);
    od = __builtin_amdgcn_mfma_f32_32x32x16_bf16(pa3, PK(l3, h3), od, 0, 0, 0);
#undef PK
}
__device__ __forceinline__ void pv_d0(f32x16* o, int vb, bf16x8 pa0, bf16x8 pa1, bf16x8 pa2, bf16x8 pa3) {
    pv_one<0>(o[0], vb, pa0, pa1, pa2, pa3); pv_one<1>(o[1], vb, pa0, pa1, pa2, pa3); pv_one<2>(o[2], vb, pa0, pa1, pa2, pa3); pv_one<3>(o[3], vb, pa0, pa1, pa2, pa3);
}
__device__ __forceinline__ void attn_dense_body(const bf16_t* __restrict__ Qb, const bf16_t* __restrict__ Kh, const bf16_t* __restrict__ Vh,
                                                bf16_t* __restrict__ Ob, int seq, char* lds) {
    int tid = threadIdx.x; asm volatile("" : "+v"(tid));
    const int wid = tid >> 6, lane = tid & 63, r32 = lane & 31, hi = lane >> 5;
    bf16_t* V_lds = (bf16_t*)lds; bf16_t* K_lds = (bf16_t*)(lds + 2 * SHM_V);
    float* ws = (float*)(lds + 2 * SHM_V + 2 * SHM_K) + wid * 64; float* li_l = ws; float* al_l = ws + 32;
    float m_reg = -1e30f, l_reg = 0; f32x16 o[4] = {}; bf16x8 qr[8];
    const bf16_t* Qw = Qb + (long)(wid * QBLK + r32) * LDQ + hi * 8;
#pragma unroll
    for (int d0 = 0; d0 < 8; ++d0) qr[d0] = *reinterpret_cast<const bf16x8*>(Qw + d0 * 16);
    const int sr = tid >> 4, sc = (tid & 15) * 8, vst0 = v_st(sr, sc), vst1 = v_st(32 + sr, sc);
    const int vb0 = (int)(uintptr_t)V_lds + v_rd_base(lane);
    struct { bf16x8 vs0, vs1, ks0, ks1; } sr_[2];
#define LD8(p) (*reinterpret_cast<const bf16x8*>(p))
#define SLOAD(i, k0) do { sr_[i].vs0 = LD8(&Vh[(long)((k0) + sr) * LDK + sc]); sr_[i].vs1 = LD8(&Vh[(long)((k0) + 32 + sr) * LDK + sc]); \
    sr_[i].ks0 = LD8(&Kh[(long)((k0) + sr) * LDK + sc]); sr_[i].ks1 = LD8(&Kh[(long)((k0) + 32 + sr) * LDK + sc]); } while (0)
#define SWRITE(b, i) do { *(bf16x8*)((char*)V_lds + (b) * SHM_V + vst0) = sr_[i].vs0;          \
    *(bf16x8*)((char*)V_lds + (b) * SHM_V + vst1) = sr_[i].vs1; int kc = sc * 2;               \
    *(bf16x8*)((char*)K_lds + (b) * SHM_K + KSWZ(sr, kc)) = sr_[i].ks0;                       \
    *(bf16x8*)((char*)K_lds + (b) * SHM_K + KSWZ(32 + sr, kc)) = sr_[i].ks1; } while (0)
#define SWAIT() asm volatile("s_waitcnt vmcnt(4)" ::: "memory")
#define RESC(a) do { if (__any((a) < 1.f)) { if (hi == 0) al_l[r32] = (a); asm volatile("s_waitcnt lgkmcnt(0)" ::: "memory"); \
    _Pragma("unroll") for (int d = 0; d < 4; ++d) _Pragma("unroll") for (int r = 0; r < 16; ++r) o[d][r] *= al_l[crow(r, hi)]; } } while (0)
    f32x16 pA0, pA1, pB0, pB1; float mnA, mnB, alA, alB; bf16x8 pa0, pa1, pa2, pa3; const int NT = seq / KVBLK;
    constexpr int SE = 0, SO = 1;
    SLOAD(SE, 0); asm volatile("s_waitcnt vmcnt(0)" ::: "memory"); SWRITE(0, SE); __syncthreads();
    qkt(pA0, pA1, K_lds, qr, r32, hi); partialSM(pA0, pA1, m_reg, mnA, alA);
    SLOAD(SO, KVBLK); if (2 < NT) SLOAD(SE, 2 * KVBLK);
    SWAIT(); SWRITE(1, SO); __syncthreads();
    for (int j = 1; j + 1 < NT; j += 2) {
        SBAR(); qkt(pB0, pB1, (bf16_t*)((char*)K_lds + SHM_K), qr, r32, hi);
        finishSM(pA0, pA1, alA, l_reg, pa0, pa1, pa2, pa3); SBAR();
        SLOAD(SO, (j + 2) * KVBLK); SBAR();
        pv_d0(o, vb0, pa0, pa1, pa2, pa3); partialSM(pB0, pB1, m_reg, mnB, alB);
        __syncthreads(); SWAIT(); SWRITE(0, SE);
        RESC(alB); __syncthreads();
        SBAR(); qkt(pA0, pA1, K_lds, qr, r32, hi);
        finishSM(pB0, pB1, alB, l_reg, pa0, pa1, pa2, pa3); SBAR();
        if (j + 3 < NT) SLOAD(SE, (j + 3) * KVBLK); SBAR();
        pv_d0(o, vb0 + (int)SHM_V, pa0, pa1, pa2, pa3); partialSM(pA0, pA1, m_reg, mnA, alA);
        __syncthreads(); SWAIT(); SWRITE(1, SO);
        RESC(alA); __syncthreads();
    }
    SBAR(); qkt(pB0, pB1, (bf16_t*)((char*)K_lds + SHM_K), qr, r32, hi);
    finishSM(pA0, pA1, alA, l_reg, pa0, pa1, pa2, pa3); SBAR();
    pv_d0(o, vb0, pa0, pa1, pa2, pa3); partialSM(pB0, pB1, m_reg, mnB, alB);
    __syncthreads(); RESC(alB);
    finishSM(pB0, pB1, alB, l_reg, pa0, pa1, pa2, pa3); SBAR();
    pv_d0(o, vb0 + (int)SHM_V, pa0, pa1, pa2, pa3);
    if (hi == 0) li_l[r32] = l_reg; asm volatile("s_waitcnt lgkmcnt(0)" ::: "memory");
    float rli[16];
#pragma unroll
    for (int r = 0; r < 16; ++r) rli[r] = __builtin_amdgcn_rcpf(li_l[crow(r, hi)]);
    bf16_t* Ow = Ob + (long)(wid * QBLK) * LDO;
#pragma unroll
    for (int r = 0; r < 16; ++r) { int orow = crow(r, hi);
#pragma unroll
        for (int d0 = 0; d0 < 4; ++d0) Ow[(long)orow * LDO + d0 * 32 + r32] = (bf16_t)f2bf(o[d0][r] * rli[r]); }
#undef LD8
#undef SLOAD
#undef SWRITE
#undef SWAIT
#undef RESC
}
}

#define XB_TMO      128
#define XB_XCNT(j)  (256  + 64 * (j))
#define XB_XSUB(j)  (1280 + 64 * (j))
#define XB_XGEN(j)  (2304 + 64 * (j))
#define XB_TOP      3328
#define XB_TOPGEN   3392
#define XCD_BAR_WORDS 3456
#define XB_SPIN_CAP (1u << 22)
__device__ __forceinline__ unsigned xb_ld(unsigned* p)              { return __hip_atomic_load(p, __ATOMIC_RELAXED, __HIP_MEMORY_SCOPE_AGENT); }
__device__ __forceinline__ unsigned xb_add(unsigned* p, unsigned v) { return __hip_atomic_fetch_add(p, v, __ATOMIC_RELAXED, __HIP_MEMORY_SCOPE_AGENT); }
__device__ __forceinline__ unsigned xb_xcc_id() { return (unsigned)__builtin_amdgcn_s_getreg((3 << 11) | 20) & 0xFu; }
#define XB_SPIN(cond, bar) do { unsigned _sp = 0; while (cond) { __builtin_amdgcn_s_sleep(1); \
    if ((++_sp & 255u) == 0u) { if (xb_ld(&(bar)[XB_TMO])) break; if (_sp > XB_SPIN_CAP) { atomicAdd(&(bar)[XB_TMO], 1u); break; } } } } while (0)
struct XcdBarrier { unsigned* bar; unsigned x; volatile LAS unsigned* st; };
__device__ __forceinline__ XcdBarrier xcd_barrier_post(unsigned* bar, volatile LAS unsigned* st) {
    XcdBarrier b; b.bar = bar; b.x = xb_xcc_id(); b.st = st;
    if (threadIdx.x == 0) (void)xb_add(&bar[XB_XCNT(b.x)], 1u);
    return b;
}
__device__ __forceinline__ void xcd_barrier_complete(unsigned* bar, unsigned x, unsigned& nloc, unsigned& nx) {
    const unsigned G = gridDim.x * gridDim.y * gridDim.z;
    unsigned sum, cnt, mine, sp = 0u;
    for (;;) {
        sum = 0u; cnt = 0u; mine = 0u;
#pragma unroll
        for (unsigned j = 0; j < 16; ++j) { const unsigned c = xb_ld(&bar[XB_XCNT(j)]); sum += c; cnt += (c > 0u) ? 1u : 0u; mine = (j == x) ? c : mine; }
        if (sum == G) break;
        __builtin_amdgcn_s_sleep(1);
        if ((++sp & 255u) == 0u) { if (xb_ld(&bar[XB_TMO])) break; if (sp > XB_SPIN_CAP) { atomicAdd(&bar[XB_TMO], 1u); break; } }
    }
    nloc = mine > 0u ? mine : 1u; nx = cnt > 0u ? cnt : 1u;
}
__device__ __forceinline__ void xcd_barrier(const XcdBarrier& b) {
    asm volatile("s_waitcnt vmcnt(0)" ::: "memory");
    __syncthreads();
    if (threadIdx.x == 0) {
        unsigned* bar = b.bar;
        __builtin_amdgcn_s_waitcnt(0);
        unsigned nloc = b.st[0], nx = b.st[1];
        if (nloc == 0u) { xcd_barrier_complete(bar, b.x, nloc, nx); b.st[0] = nloc; b.st[1] = nx; }
        const unsigned old = xb_add(&bar[XB_XSUB(b.x)], 1u);
        const unsigned gen = old / nloc;
        if (old + 1u == (gen + 1u) * nloc) {
            __builtin_amdgcn_fence(__ATOMIC_RELEASE, "agent");
            asm volatile("s_waitcnt vmcnt(0)" ::: "memory");
            const unsigned og = xb_add(&bar[XB_TOP], 1u);
            const unsigned tg = og / nx;
            if (og + 1u == (tg + 1u) * nx) xb_add(&bar[XB_TOPGEN], 1u);
            else XB_SPIN(xb_ld(&bar[XB_TOPGEN]) == tg, bar);
            __builtin_amdgcn_fence(__ATOMIC_ACQUIRE, "agent");
            xb_add(&bar[XB_XGEN(b.x)], 1u);
            asm volatile("s_waitcnt vmcnt(0)" ::: "memory");
        } else {
            XB_SPIN(xb_ld(&bar[XB_XGEN(b.x)]) == gen, bar);
            __builtin_amdgcn_fence(__ATOMIC_ACQUIRE, "agent");
            asm volatile("s_waitcnt vmcnt(0)" ::: "memory");
        }
    }
    __syncthreads();
}

struct Params { const float* in[15]; float* out; unsigned char* ws; int nsteps; int pad; int steps[128]; };
enum Kind { K_INIT = 0, K_GU, K_GV, K_SG, K_GO, K_EA, K_M1, K_M2, K_EB, K_QKV, K_QKN, K_ATT, K_WO, K_CDS, K_CDP, K_F1, K_PD, K_F3, K_CO, K_COS };
enum In { I_XP = 0, I_XS, I_NG, I_AWIN, I_AVN, I_AWS, I_ABS, I_AWOUT, I_BQKV, I_BQN, I_BKN, I_BWO, I_CWOUT, I_MWIN, I_MWOUT };

__device__ __forceinline__ void transpose_item(const float* W, int K, int N, bf16_t* WT, LAS float* scr, int item, int lane, const float* gk) {
    const int nblk = N / 32, kb = item / nblk, nb = item % nblk, k0 = 64 * kb, n0 = 32 * nb;
#pragma unroll 8
    for (int i = 0; i < 32; ++i) { const int kk = 2 * i + (lane >> 5); scr[kk * 33 + (lane & 31)] = W[(size_t)(k0 + kk) * N + n0 + (lane & 31)]; }
    LDS_WAIT(); asm volatile("" ::: "memory");
    const int c = lane & 7;
    const f32x4 one4 = {1.f, 1.f, 1.f, 1.f};
    const f32x4 g0 = gk ? *(const f32x4*)(gk + k0 + 8 * c) : one4, g1 = gk ? *(const f32x4*)(gk + k0 + 8 * c + 4) : one4;
#pragma unroll
    for (int j = 0; j < 4; ++j) { const int n = (lane >> 3) + 8 * j; const LAS float* s = scr + (8 * c) * 33 + n;
        u32x4 o; o.x = pk2(s[0 * 33] * g0[0], s[1 * 33] * g0[1]); o.y = pk2(s[2 * 33] * g0[2], s[3 * 33] * g0[3]); o.z = pk2(s[4 * 33] * g1[0], s[5 * 33] * g1[1]); o.w = pk2(s[6 * 33] * g1[2], s[7 * 33] * g1[3]);
        *(u32x4*)(WT + (size_t)(n0 + n) * K + k0 + 8 * c) = o; }
    LDS_WAIT(); asm volatile("" ::: "memory");
}
__device__ __forceinline__ void transpose_job(const float* W, int K, int N, bf16_t* WT, LAS float* scr, int gw, int NGW, int lane_, const float* gk) {
    int lane = lane_; asm volatile("" : "+v"(lane));
    const int nitems = (K / 64) * (N / 32);
    for (int it = gw; it < nitems; it += NGW) transpose_item(W, K, N, WT, scr, it, lane, gk);
}
__device__ __forceinline__ void convert_layer(const Params& p, int L, LAS float* scr, int gw, int NGW, int lane) {
    unsigned char* ws = p.ws; const int m = L % 3, j = L / 3;
    const float* ngL = p.in[I_NG] + (size_t)L * 4 * DM;
    if (m == 0) {
        transpose_job(p.in[I_AWIN] + (size_t)j * DM * 2 * AW, DM, 2 * AW, (bf16_t*)(ws + WS_WMIX), scr, gw, NGW, lane, ngL);
        transpose_job(p.in[I_AWOUT] + (size_t)j * AW * DM, AW, DM, (bf16_t*)(ws + WS_WMIX2_A), scr, gw, NGW, lane, nullptr);
    } else if (m == 1) {
        transpose_job(p.in[I_BQKV] + (size_t)j * DM * QKVW, DM, QKVW, (bf16_t*)(ws + WS_WMIX), scr, gw, NGW, lane, ngL);
        transpose_job(p.in[I_BWO] + (size_t)j * DM * DM, DM, DM, (bf16_t*)(ws + WS_WMIX2_B), scr, gw, NGW, lane, nullptr);
    } else {
        transpose_job(p.in[I_CWOUT] + (size_t)j * DM * DM, DM, DM, (bf16_t*)(ws + WS_WMIX), scr, gw, NGW, lane, nullptr);
    }
    transpose_job(p.in[I_MWIN] + (size_t)L * DM * DFF, DM, DFF, (bf16_t*)(ws + WS_WMI), scr, gw, NGW, lane, ngL + 2 * DM);
    transpose_job(p.in[I_MWOUT] + (size_t)L * DFF * DM, DFF, DM, (bf16_t*)(ws + WS_WMO), scr, gw, NGW, lane, nullptr);
}

__device__ __forceinline__ void rows_phase(const float* xin_p, const float* xin_s, bf16_t* XB, const bf16_t* y, const float* ga, float* rs, float* fout,
                                           int gw, int NGW, int lane_) {
    int lane = lane_; asm volatile("" : "+v"(lane));
    if (xin_p) {
        for (int row = gw; row < NTOK; row += NGW) {
            const float* xr = row < NPROMPT ? xin_p + (size_t)row * DM : xin_s + (size_t)(row - NPROMPT) * DM;
            f32x4 v[4];
#pragma unroll
            for (int j = 0; j < 4; ++j) v[j] = *(const f32x4*)(xr + 4 * lane + 256 * j);
            bf16_t* xo = XB + (size_t)row * DM; float s2 = 0.f;
#pragma unroll
            for (int j = 0; j < 4; ++j) { u32x2 w; w.x = pk2(v[j][0], v[j][1]); w.y = pk2(v[j][2], v[j][3]); *(u32x2*)(xo + 4 * lane + 256 * j) = w;
                const float a = bf_lo(w.x), b = bf_hi(w.x), c = bf_lo(w.y), d = bf_hi(w.y); s2 += (a * a + b * b) + (c * c + d * d); }
            const float r2 = 1.0f / sqrtf(wave_sum(s2) * (1.0f / DM) + EPS);
            if (lane == 0) rs[row] = r2;
        }
        return;
    }
    f32x4 A[4];
#pragma unroll
    for (int j = 0; j < 4; ++j) A[j] = *(const f32x4*)(ga + 4 * lane + 256 * j);
    u32x2 xa[4], ya[4], xb[4], yb[4];
    if (gw < NTOK) {
#pragma unroll
        for (int j = 0; j < 4; ++j) { xa[j] = *(const u32x2*)(XB + (size_t)gw * DM + 4 * lane + 256 * j); ya[j] = *(const u32x2*)(y + (size_t)gw * DM + 4 * lane + 256 * j); }
    }
    for (int row = gw; row < NTOK; row += NGW) {
        const int nrow = row + NGW < NTOK ? row + NGW : row;
#pragma unroll
        for (int j = 0; j < 4; ++j) { xb[j] = *(const u32x2*)(XB + (size_t)nrow * DM + 4 * lane + 256 * j); yb[j] = *(const u32x2*)(y + (size_t)nrow * DM + 4 * lane + 256 * j); }
        f32x4 v[4], yy[4]; float s = 0.f;
#pragma unroll
        for (int j = 0; j < 4; ++j) { v[j] = (f32x4){bf_lo(xa[j].x), bf_hi(xa[j].x), bf_lo(xa[j].y), bf_hi(xa[j].y)};
            yy[j] = (f32x4){bf_lo(ya[j].x), bf_hi(ya[j].x), bf_lo(ya[j].y), bf_hi(ya[j].y)};
            s += (yy[j][0] * yy[j][0] + yy[j][1] * yy[j][1]) + (yy[j][2] * yy[j][2] + yy[j][3] * yy[j][3]); }
        const float r = 1.0f / sqrtf(wave_sum(s) * (1.0f / DM) + EPS);
#pragma unroll
        for (int j = 0; j < 4; ++j) v[j] = v[j] + (yy[j] * r) * A[j];
        if (fout) {
            float* xo = fout + (size_t)row * DM;
#pragma unroll
            for (int j = 0; j < 4; ++j) *(f32x4*)(xo + 4 * lane + 256 * j) = v[j];
        } else {
            bf16_t* xo = XB + (size_t)row * DM; float s2 = 0.f;
#pragma unroll
            for (int j = 0; j < 4; ++j) { u32x2 w; w.x = pk2(v[j][0], v[j][1]); w.y = pk2(v[j][2], v[j][3]); *(u32x2*)(xo + 4 * lane + 256 * j) = w;
                const float a = bf_lo(w.x), b = bf_hi(w.x), c = bf_lo(w.y), d = bf_hi(w.y); s2 += (a * a + b * b) + (c * c + d * d); }
            const float r2 = 1.0f / sqrtf(wave_sum(s2) * (1.0f / DM) + EPS);
            if (lane == 0) rs[row] = r2;
        }
#pragma unroll
        for (int j = 0; j < 4; ++j) { xa[j] = xb[j]; ya[j] = yb[j]; }
    }
}

__device__ __forceinline__ void consts_phase(const Params& p, size_t gt, size_t NGT) {
    unsigned char* ws = p.ws;
    { bf16_t* o = (bf16_t*)(ws + WS_WS); const float* s = p.in[I_AWS]; for (size_t i = gt; i < 2u * 8 * 128 * 128; i += NGT) o[i] = (bf16_t)f2bf(s[i]); }
    { bf16_t* o = (bf16_t*)(ws + WS_G); const float sc = 0.08838834764831845f;
      const float* g2 = p.in[I_NG] + (size_t)2 * 4 * DM;
      for (size_t i = gt; i < 2048u * 256; i += NGT) { const int row = (int)(i >> 8), kk = (int)(i & 255), ri = row >> 10, col = row & 1023, g = col >> 7, l = col & 127;
          float v = 0.f; if ((g & 1) == (kk >> 7)) { const float tr = (float)((l * (kk & 127)) & 127) * (1.0f / 128.0f); v = ri ? -__builtin_amdgcn_sinf(tr) : __builtin_amdgcn_cosf(tr); }
          o[i] = (bf16_t)f2bf(v * sc * g2[256 * (col >> 8) + kk]); } }
    { bf16_t* o1 = (bf16_t*)(ws + WS_T1); bf16_t* o3 = (bf16_t*)(ws + WS_T3); const float sc = 0.08838834764831845f;
      for (size_t i = gt; i < 256u * 256; i += NGT) { const int row = (int)(i >> 8), kk = (int)(i & 255), ro = row >> 7, k1 = row & 127, ri = kk >> 7, s1 = kk & 127;
          const float tr = (float)((k1 * s1) & 127) * (1.0f / 128.0f); const float cv = __builtin_amdgcn_cosf(tr), sv = __builtin_amdgcn_sinf(tr);
          const float t1 = (ro == ri) ? cv : (ro == 0 ? sv : -sv);
          o1[i] = (bf16_t)f2bf(t1 * sc);
          const float t3 = ro ? 0.f : (ri ? sv : cv);
          o3[i] = (bf16_t)f2bf(t3 * sc); } }
    { bf16_t* o = (bf16_t*)(ws + WS_DP); const float sc = 0.022097086912079608f;
      for (size_t i = gt; i < 2048u * 4096; i += NGT) { const int k = (int)(i >> 12), kk = (int)(i & 4095), ri = kk >> 11, s = kk & 2047;
          const float tr = (float)((k * s) & 2047) * (1.0f / 2048.0f); const float v = ri ? __builtin_amdgcn_sinf(tr) : __builtin_amdgcn_cosf(tr);
          o[i] = (bf16_t)f2bf(v * sc); } }
}

__device__ __forceinline__ void qkn_phase(bf16_t* qkv, const float* qn, const float* kn, int gw, int NGW, int lane_, bool dry) {
    int lane = lane_; asm volatile("" : "+v"(lane));
    const int sec = lane >> 5, i = lane & 31, d1 = sec * 64 + i, d2 = d1 + 32;
    const float inv_freq = __builtin_amdgcn_exp2f(-13.287712379549449f * (float)i * (1.0f / 32.0f));
    const float gq1 = qn[d1], gq2 = qn[d2], gk1 = kn[d1], gk2 = kn[d2];
    for (int tok = gw; tok < NTOK; tok += NGW) {
        const int t = tok < NPROMPT ? (tok & (SEQP - 1)) : tok - NPROMPT;
        const float pos = (float)(sec ? (t & 63) : (t >> 6));
        const float ang = pos * inv_freq, cs = __cosf(ang), sn = __sinf(ang);
        bf16_t* row = qkv + (size_t)tok * QKVW;
        unsigned short v1[10], v2[10];
#pragma unroll
        for (int hh = 0; hh < 10; ++hh) { v1[hh] = row[hh * 128 + d1]; v2[hh] = row[hh * 128 + d2]; }
#pragma unroll
        for (int hh = 0; hh < 10; ++hh) {
            const float x1 = __builtin_bit_cast(float, (unsigned)v1[hh] << 16), x2 = __builtin_bit_cast(float, (unsigned)v2[hh] << 16);
            const float r = 1.0f / sqrtf(wave_sum(x1 * x1 + x2 * x2) * (1.0f / 128.0f) + EPS);
            const float y1 = x1 * r * (hh < 8 ? gq1 : gk1), y2 = x2 * r * (hh < 8 ? gq2 : gk2);
            bf16_t o1 = (bf16_t)f2bf(y1 * cs - y2 * sn), o2 = (bf16_t)f2bf(y1 * sn + y2 * cs);
            if (dry && y1 != 12345.678f) { o1 = v1[hh]; o2 = v2[hh]; }
            row[hh * 128 + d1] = o1; row[hh * 128 + d2] = o2;
        }
    }
}

__device__ __forceinline__ void spatial_phase(LAS unsigned char* lds, const bf16_t* wsbf, const bf16_t* VT, bf16_t* U, const float* sumsq, const float* gain, const float* bs,
                                              int G, int bid, bool dry) {
    int tid = threadIdx.x; asm volatile("" : "+v"(tid));
    const int wid = tid >> 6, lane = tid & 63, l15 = lane & 15, lq = lane >> 4;
    constexpr int PITCH = 272;
    LAS float* rvs = (LAS float*)(lds + 128 * PITCH);
    const int pr = tid >> 2, qs = (tid & 3) * 32;
    float sacc = 0.f; u32x4 wraw[4];
    if (bid < 1024) {
        const int c0 = bid >> 3, g0 = bid & 7;
        if (tid < 128) {
#pragma unroll
            for (int k = 0; k < 24; ++k) sacc += sumsq[(size_t)k * NTOK + c0 * 128 + tid];
        }
        const bf16_t* src = wsbf + ((size_t)g0 * 128 + pr) * 128 + qs;
#pragma unroll
        for (int k = 0; k < 4; ++k) wraw[k] = *(const u32x4*)(src + 8 * k);
    }
    for (int item = bid; item < 1024; item += G) {
        const int c = item >> 3, g = item & 7;
        if (tid < 128) rvs[tid] = 1.0f / sqrtf(sacc * (1.0f / AW) + EPS);
        bf16x8 bfr[3][4];
#pragma unroll
        for (int db = 0; db < 3; ++db)
#pragma unroll
            for (int ks = 0; ks < 4; ++ks)
                bfr[db][ks] = *(const bf16x8*)(VT + (size_t)(g * 384 + (3 * wid + db) * 16 + l15) * SLAB + c * 128 + ks * 32 + lq * 8);
        bf16_t* ubase = U + (size_t)(c * 128 + l15) * AW + g * 384 + 3 * wid * 16 + lq * 4;
        u32x2 uv[8][3]; float bsv[8]; f32x4 gn[3];
#pragma unroll
        for (int pb = 0; pb < 8; ++pb) { bsv[pb] = bs[g * 128 + pb * 16 + l15];
#pragma unroll
            for (int db = 0; db < 3; ++db) uv[pb][db] = *(const u32x2*)(ubase + (size_t)(pb * 16) * AW + db * 16); }
#pragma unroll
        for (int db = 0; db < 3; ++db) gn[db] = *(const f32x4*)(gain + g * 384 + (3 * wid + db) * 16 + lq * 4);
        __syncthreads();
        {
#pragma unroll
          for (int k = 0; k < 4; ++k) { const u32x4 w = wraw[k]; u32x4 o;
              const LAS float* rq = rvs + qs + 8 * k;
              o.x = pk2(bf_lo(w.x) * rq[0], bf_hi(w.x) * rq[1]); o.y = pk2(bf_lo(w.y) * rq[2], bf_hi(w.y) * rq[3]);
              o.z = pk2(bf_lo(w.z) * rq[4], bf_hi(w.z) * rq[5]); o.w = pk2(bf_lo(w.w) * rq[6], bf_hi(w.w) * rq[7]);
              *(LAS u32x4*)(lds + pr * PITCH + (qs + 8 * k) * 2) = o; } }
        {
            const int nitem = item + G;
            sacc = 0.f;
            if (nitem < 1024) {
                const int cn = nitem >> 3, gn_ = nitem & 7;
                if (tid < 128) {
#pragma unroll
                    for (int k = 0; k < 24; ++k) sacc += sumsq[(size_t)k * NTOK + cn * 128 + tid];
                }
                const bf16_t* src = wsbf + ((size_t)gn_ * 128 + pr) * 128 + qs;
#pragma unroll
                for (int k = 0; k < 4; ++k) wraw[k] = *(const u32x4*)(src + 8 * k);
            }
        }
        __syncthreads();
#pragma unroll
        for (int pb = 0; pb < 8; ++pb) {
            bf16x8 af[4];
#pragma unroll
            for (int ks = 0; ks < 4; ++ks) af[ks] = *(const LAS bf16x8*)(lds + (pb * 16 + l15) * PITCH + ks * 64 + lq * 16);
            const float bias = bsv[pb];
#pragma unroll
            for (int db = 0; db < 3; ++db) {
                f32x4 a = {0.f, 0.f, 0.f, 0.f};
#pragma unroll
                for (int ks = 0; ks < 4; ++ks) a = __builtin_amdgcn_mfma_f32_16x16x32_bf16(bfr[db][ks], af[ks], a, 0, 0, 0);
                const u32x2 uu = uv[pb][db];
                const f32x4 sv = a * gn[db] + bias;
                u32x2 o; o.x = pk2(bf_lo(uu.x) * sv[0], bf_hi(uu.x) * sv[1]); o.y = pk2(bf_lo(uu.y) * sv[2], bf_hi(uu.y) * sv[3]);
                if (dry && sv[0] != 12345.678f) o = uu;
                *(u32x2*)(ubase + (size_t)(pb * 16) * AW + db * 16) = o;
            }
        }
        __syncthreads();
    }
}

__device__ __forceinline__ void std_desc(pg8::Desc& d, const bf16_t* A, unsigned lda, int M, const bf16_t* B, unsigned ldb, int N, int K, bf16_t* C, unsigned ldc, int mode) {
    d.A = (const char*)A; d.B = (const char*)B; d.lda = lda; d.ldb = ldb; d.ahs = 128u * lda * 2u; d.bhs = 128u * ldb * 2u;
    d.nt = K / 64; d.kmask = 0x3fffffff; d.kshift = 30; d.kpA = 0; d.kpB = 0;
    d.nM = M / 256; d.nN = N / 256; d.nZ = 1; d.a_z = 0; d.a_m = 256u * lda * 2u; d.b_z = 0; d.b_m = 0; d.b_n = 256u * ldb * 2u;
    d.c_z = 0; d.c_m = 256u * ldc; d.c_n = 256; d.C = C; d.ldc = ldc; d.mode = mode; d.aux = nullptr; d.rsc = nullptr; d.csc = nullptr; d.cperm = 0;
}

__global__ void __launch_bounds__(512, 2) mega_fwd(Params p) {
    extern __shared__ __attribute__((aligned(16))) unsigned char lds_raw[];
    LAS unsigned char* lds = (LAS unsigned char*)lds_raw;
    cg::grid_group grid = cg::this_grid();
    const int G = gridDim.x, bid = blockIdx.x, NGW = G * 8;
    unsigned char* ws = p.ws;
    bf16_t* H = (bf16_t*)(ws + WS_H); bf16_t* Y = (bf16_t*)(ws + WS_Y); bf16_t* BIG = (bf16_t*)(ws + WS_BIG);
    bf16_t* WMIX = (bf16_t*)(ws + WS_WMIX); float* sumsq = (float*)(ws + WS_PART); float* RS = (float*)(ws + WS_RS);
    bf16_t* OB = BIG + (size_t)72 * MiB;
    bf16_t* FP = BIG + (size_t)96 * MiB;

    volatile LAS unsigned* bst = (volatile LAS unsigned*)(lds + 131072 + 512);
    if (threadIdx.x < 2) bst[threadIdx.x] = 0u;
    __syncthreads();
    grid.sync();
    const XcdBarrier xbar = xcd_barrier_post((unsigned*)(ws + WS_SUMSQ), bst);
    for (int st = 0; st < p.nsteps; ++st) {
        const int code = p.steps[st], kind = code & 0xff, L = (code >> 8) & 0xf, s = (code >> 12) & 0xf, do_sync = (code >> 16) & 1; const bool dry = (code >> 17) & 1;
        const int j = L / 3;
        const float* ng = p.in[I_NG] + (size_t)L * 4 * DM;
        bool is_gemm = false; pg8::Desc d;
        int tid = threadIdx.x; asm volatile("" : "+v"(tid));
        const int lane = tid & 63, wave = __builtin_amdgcn_readfirstlane(tid >> 6), gw = bid * 8 + wave;
        LAS float* scr = (LAS float*)(lds + wave * 16384);
        switch (kind) {
        case K_INIT: {
            consts_phase(p, (size_t)bid * 512 + tid, (size_t)G * 512);
            convert_layer(p, 0, scr, gw, NGW, lane);
            rows_phase(p.in[I_XP], p.in[I_XS], H, nullptr, nullptr, RS, nullptr, gw, NGW, lane);
        } break;
        case K_EA: rows_phase(nullptr, nullptr, H, Y, ng + DM, RS, nullptr, gw, NGW, lane); break;
        case K_EB: {
            if (L < 3) {
                convert_layer(p, L + 1, scr, gw, NGW, lane);
                rows_phase(nullptr, nullptr, H, Y, ng + 3 * DM, RS, nullptr, gw, NGW, lane);
            } else rows_phase(nullptr, nullptr, H, Y, ng + 3 * DM, nullptr, p.out, gw, NGW, lane);
        } break;
        case K_QKN: qkn_phase(BIG, p.in[I_BQN] + j * 128, p.in[I_BKN] + j * 128, gw, NGW, lane, dry); break;
#ifndef NO_SG
        case K_SG: spatial_phase(lds, (const bf16_t*)(ws + WS_WS) + (size_t)j * 8 * 128 * 128, BIG + (size_t)SLAB * AW, BIG, sumsq + s * SLAB,
                                 p.in[I_AVN] + j * AW, p.in[I_ABS] + j * 8 * 128, G, bid, dry); break;
#endif
        case K_ATT: {
            for (int U = bid; U < 1536; U += G) {
                int h, qb, tokbase, seq;
                if (U < 512) { h = U & 7; qb = U >> 3; tokbase = NPROMPT; seq = NSAMPLE; }
                else { const int V = U - 512, x = V & 7, v = V >> 3, b = x + 8 * (v >> 6), w = v & 63; h = w >> 3; qb = w & 7; tokbase = b * SEQP; seq = SEQP; }
                const bf16_t* Q = BIG + (size_t)(tokbase + qb * 256) * QKVW + h * 128;
                const bf16_t* Kp = BIG + (size_t)tokbase * QKVW + 1024 + (h >> 2) * 128;
                const bf16_t* Vp = Kp + 256;
                bf16_t* O = OB + (size_t)(tokbase + qb * 256) * DM + h * 128;
#ifndef NO_ATT
                att::attn_dense_body(Q, Kp, Vp, O, seq, (char*)lds_raw);
#endif
                __syncthreads();
            }
        } break;
        case K_GU: is_gemm = true; std_desc(d, H + (size_t)s * SLAB * DM, DM, SLAB, WMIX, DM, AW, DM, BIG, AW, 1); d.rsc = RS + s * SLAB; break;
        case K_GV: is_gemm = true; std_desc(d, WMIX + (size_t)AW * DM, DM, AW, H + (size_t)s * SLAB * DM, DM, SLAB, DM, BIG + (size_t)SLAB * AW, SLAB, 3); d.aux = sumsq + s * SLAB; d.csc = RS + s * SLAB; break;
        case K_GO: is_gemm = true; std_desc(d, BIG, AW, SLAB, (const bf16_t*)(ws + WS_WMIX2_A), AW, DM, AW, Y + (size_t)s * SLAB * DM, DM, 0); break;
        case K_M1: is_gemm = true; std_desc(d, H + (size_t)s * SLAB * DM, DM, SLAB, (const bf16_t*)(ws + WS_WMI), DM, DFF, DM, BIG, DFF, 2); d.rsc = RS + s * SLAB; break;
        case K_M2: is_gemm = true; std_desc(d, BIG, DFF, SLAB, (const bf16_t*)(ws + WS_WMO), DFF, DM, DFF, Y + (size_t)s * SLAB * DM, DM, 0); break;
        case K_QKV: is_gemm = true; std_desc(d, H, DM, NTOK, WMIX, DM, QKVW, DM, BIG, QKVW, 0); d.rsc = RS; break;
        case K_WO: is_gemm = true; std_desc(d, OB, DM, NTOK, (const bf16_t*)(ws + WS_WMIX2_B), DM, DM, DM, Y, DM, 0); break;
        case K_CO: is_gemm = true; std_desc(d, FP, DM, NPROMPT, WMIX, DM, DM, DM, Y, DM, 0); break;
        case K_COS: is_gemm = true; std_desc(d, BIG, DM, NSAMPLE, WMIX, DM, DM, DM, Y + (size_t)NPROMPT * DM, DM, 0); break;
        case K_CDS: {
            is_gemm = true; std_desc(d, (const bf16_t*)(ws + WS_G), 256, 1024, H + (size_t)NPROMPT * DM, 128 * DM, NSAMPLE, 256, BIG, NSAMPLE, 0);
            d.nZ = 2; d.a_z = 1024u * 256 * 2; d.bhs = DM * 2u; d.b_m = 512; d.b_n = 2u * DM * 2; d.c_z = 1024u * NSAMPLE; d.csc = RS + NPROMPT; d.cperm = 1;
        } break;
        case K_CDP: {
            is_gemm = true; std_desc(d, (const bf16_t*)(ws + WS_G), 256, 1024, H, DM, NPROMPT, 256, BIG + (size_t)32 * MiB, NPROMPT, 0);
            d.nZ = 2; d.a_z = 1024u * 256 * 2; d.b_m = 512; d.c_z = 1024u * NPROMPT; d.csc = RS;
        } break;
        case K_F1: {
            is_gemm = true; std_desc(d, (const bf16_t*)(ws + WS_T1), 256, 256, BIG, 128, 131072, 256, Y, 131072, 4);
            d.kmask = 1; d.kshift = 1; d.kpA = 256; d.kpB = 1024u * NSAMPLE * 2;
        } break;
        case K_PD: {
            is_gemm = true; std_desc(d, (const bf16_t*)(ws + WS_DP), 4096, 2048, BIG + (size_t)32 * MiB, NPROMPT, 1024, 4096, FP, DM, 0);
            d.nZ = 16; d.b_z = SEQP * 2u; d.kmask = 31; d.kshift = 5; d.kpA = 4096; d.kpB = 1024u * NPROMPT * 2; d.c_z = (unsigned)SEQP * DM;
        } break;
        case K_F3: {
            is_gemm = true; std_desc(d, (const bf16_t*)(ws + WS_T3), 256, 256, Y, 128, 1024, 256, BIG, 128 * DM, 5);
            d.nZ = 128; d.b_z = 131072u * 2; d.kmask = 1; d.kshift = 1; d.kpA = 256; d.kpB = 128u * 131072 * 2; d.c_z = DM; d.c_m = 0;
        } break;
        default: break;
        }
#ifndef NO_GEMM
        if (is_gemm) { if (dry) d.mode |= 8; pg8::gemm_phase(lds, d, G, bid); }
#endif
#ifdef DBG_DUP_SYNC
        if (do_sync && st != 0) xcd_barrier(xbar);
#endif
        if (do_sync) xcd_barrier(xbar);
    }
}

static inline int enc(int kind, int layer, int slab, int sync) { return kind | (layer << 8) | (slab << 12) | (sync << 16); }
extern "C" void kernel_launch(void* const* d_in, const int* in_sizes, int n_in, void* d_out, int out_size, void* d_ws, size_t ws_size, hipStream_t stream) {
    static int grid = 0;
    if (grid == 0) {
        if (n_in != 15 || ws_size < WS_END) { fprintf(stderr, "kernel_launch: unexpected n_in %d / ws_size %zu\n", n_in, ws_size); grid = -1; return; }
        int dev = 0, cus = 0, per_cu = 0;
        hipGetDevice(&dev); hipDeviceGetAttribute(&cus, hipDeviceAttributeMultiprocessorCount, dev);
        if (hipFuncSetAttribute((const void*)mega_fwd, hipFuncAttributeMaxDynamicSharedMemorySize, LDS_BYTES) != hipSuccess) { fprintf(stderr, "hipFuncSetAttribute failed\n"); grid = -1; return; }
        if (hipOccupancyMaxActiveBlocksPerMultiprocessor(&per_cu, (const void*)mega_fwd, 512, LDS_BYTES) != hipSuccess || per_cu < 1) { fprintf(stderr, "occupancy query: %d\n", per_cu); per_cu = 1; }
        (void)hipGetLastError();
        grid = cus * 1;
        fprintf(stderr, "kernel_launch: grid %d (per_cu %d) ws %zu\n", grid, per_cu, ws_size);
    }
    if (grid < 0) return;
    Params p{};
    for (int i = 0; i < 15; ++i) p.in[i] = (const float*)d_in[i];
    p.out = (float*)d_out; p.ws = (unsigned char*)d_ws;
    int n = 0;
    p.steps[n++] = enc(K_INIT, 0, 0, 1);
#ifdef DBG_DUP_INIT
    p.steps[n++] = enc(K_INIT, 0, 0, 1);
#endif
    for (int L = 0; L < 4; ++L) {
        const int m = L % 3;
        if (m == 0) {
            for (int s = 0; s < 3; ++s) { p.steps[n++] = enc(K_GU, L, s, 0); p.steps[n++] = enc(K_GV, L, s, 1);
#ifdef DBG_DUP_GMLP
                p.steps[n++] = enc(K_GU, L, s, 0); p.steps[n++] = enc(K_GV, L, s, 1);
#endif

#ifdef DBG_DUP_SG
                p.steps[n++] = enc(K_SG, L, s, 1) | (1 << 17);
#endif
                p.steps[n++] = enc(K_SG, L, s, 1); p.steps[n++] = enc(K_GO, L, s, 1);
#ifdef DBG_DUP_GMLP
                p.steps[n++] = enc(K_GO, L, s, 1);
#endif
            }
        } else if (m == 1) {
            p.steps[n++] = enc(K_QKV, L, 0, 1);
#ifdef DBG_DUP_MISC
            p.steps[n++] = enc(K_QKV, L, 0, 1);
#endif

#ifdef DBG_DUP_QKN
            p.steps[n++] = enc(K_QKN, L, 0, 1) | (1 << 17);
#endif
            p.steps[n++] = enc(K_QKN, L, 0, 1); p.steps[n++] = enc(K_ATT, L, 0, 1);
#ifdef DBG_DUP_ATT
            p.steps[n++] = enc(K_ATT, L, 0, 1);
#endif
 p.steps[n++] = enc(K_WO, L, 0, 1);
#ifdef DBG_DUP_MISC
            p.steps[n++] = enc(K_WO, L, 0, 1);
#endif
        } else {
#if defined(DBG_SKIP_S)
            p.steps[n++] = enc(K_CDP, L, 0, 1); p.steps[n++] = enc(K_PD, L, 0, 1); p.steps[n++] = enc(K_CO, L, 0, 0); p.steps[n++] = enc(K_COS, L, 0, 1);
#elif defined(DBG_SKIP_P)
            p.steps[n++] = enc(K_CDS, L, 0, 1); p.steps[n++] = enc(K_F1, L, 0, 1); p.steps[n++] = enc(K_F3, L, 0, 1); p.steps[n++] = enc(K_CO, L, 0, 0); p.steps[n++] = enc(K_COS, L, 0, 1);
#else
            p.steps[n++] = enc(K_CDS, L, 0, 0); p.steps[n++] = enc(K_CDP, L, 0, 1); p.steps[n++] = enc(K_F1, L, 0, 0); p.steps[n++] = enc(K_PD, L, 0, 1);
            p.steps[n++] = enc(K_F3, L, 0, 1); p.steps[n++] = enc(K_CO, L, 0, 0); p.steps[n++] = enc(K_COS, L, 0, 1);
#ifdef DBG_DUP_MISC
            p.steps[n++] = enc(K_CO, L, 0, 0); p.steps[n++] = enc(K_COS, L, 0, 1);
#endif
#ifdef DBG_DUP_FFT
            p.steps[n++] = enc(K_CDS, L, 0, 0); p.steps[n++] = enc(K_CDP, L, 0, 1); p.steps[n++] = enc(K_F1, L, 0, 0); p.steps[n++] = enc(K_PD, L, 0, 1);
            p.steps[n++] = enc(K_F3, L, 0, 1); p.steps[n++] = enc(K_CO, L, 0, 0); p.steps[n++] = enc(K_COS, L, 0, 1);
#endif
#endif
        }
        p.steps[n++] = enc(K_EA, L, 0, 1);
        for (int s = 0; s < 3; ++s) { p.steps[n++] = enc(K_M1, L, s, 1);
#ifdef DBG_DUP_MLP
            p.steps[n++] = enc(K_M1, L, s, 1) | (DBG_DUP_MLP << 17); p.steps[n++] = enc(K_M2, L, s, 1) | (DBG_DUP_MLP << 17);
#endif
            p.steps[n++] = enc(K_M2, L, s, 1); }
        p.steps[n++] = enc(K_EB, L, 0, L < 3 ? 1 : 0);
    }
#ifdef DBG_STEPS
    if (n > DBG_STEPS) n = DBG_STEPS;
#endif
    p.nsteps = n;
    if (hipMemsetAsync(d_ws, 0, 16384, stream) != hipSuccess) { fprintf(stderr, "memset failed\n"); return; }
    void* args[] = {&p};
    hipError_t e = hipLaunchCooperativeKernel((const void*)mega_fwd, dim3(grid), dim3(512), args, LDS_BYTES, stream);
    if (e != hipSuccess) fprintf(stderr, "cooperative launch failed: %s (grid %d)\n", hipGetErrorString(e), grid);
}
```

```cpp
#include <hip/hip_runtime.h>
#include <hip/hip_cooperative_groups.h>
#include <cstdio>
#include <cstdint>
namespace cg = cooperative_groups;

#define LAS __attribute__((address_space(3)))
#define GAS __attribute__((address_space(1)))
typedef unsigned short bf16_t;
typedef short bf16x8 __attribute__((ext_vector_type(8)));
typedef short s16x4 __attribute__((ext_vector_type(4)));
typedef float f32x4 __attribute__((ext_vector_type(4)));
typedef float f32x2 __attribute__((ext_vector_type(2)));
typedef float f32x16 __attribute__((ext_vector_type(16)));
typedef unsigned u32x4 __attribute__((ext_vector_type(4)));
typedef unsigned u32x2 __attribute__((ext_vector_type(2)));

constexpr int DM = 1024, NTOK = 49152, NPROMPT = 32768, NSAMPLE = 16384, SEQP = 2048, SLAB = 16384;
constexpr int AW = 3072, DFF = 4096, QKVW = 1536;
constexpr float EPS = 1e-6f;
constexpr size_t MiB = 1u << 20;
constexpr size_t WS_SUMSQ = 0;
constexpr size_t WS_WS = 1 * MiB;
constexpr size_t WS_G = 2 * MiB;
constexpr size_t WS_T1 = 3 * MiB;
constexpr size_t WS_T3 = 3 * MiB + 256 * 1024;
constexpr size_t WS_DP = 4 * MiB;
constexpr size_t WS_WMIX = 20 * MiB;
constexpr size_t WS_WMIX2_A = WS_WMIX + 12 * MiB;
constexpr size_t WS_WMIX2_B = WS_WMIX + 4 * MiB;
constexpr size_t WS_WMI = 40 * MiB, WS_WMO = 48 * MiB;
constexpr size_t WS_H = 56 * MiB;
constexpr size_t WS_Y = 152 * MiB;
constexpr size_t WS_BIG = 248 * MiB;
constexpr size_t WS_PART = 504 * MiB;
constexpr size_t WS_END = 509 * MiB;
constexpr size_t WS_RS = 65536;
constexpr int LDS_BYTES = 147456;

__device__ __forceinline__ unsigned f2bf(float f) { unsigned u = __builtin_bit_cast(unsigned, f); return (u + 0x7fffu + ((u >> 16) & 1u)) >> 16; }
__device__ __forceinline__ unsigned pk2(float lo, float hi) { return f2bf(lo) | (f2bf(hi) << 16); }
__device__ __forceinline__ unsigned cvt_pk_bf16(float lo, float hi) { unsigned r; asm volatile("v_cvt_pk_bf16_f32 %0, %1, %2" : "=v"(r) : "v"(lo), "v"(hi)); return r; }
__device__ __forceinline__ float bf_lo(unsigned u) { return __builtin_bit_cast(float, u << 16); }
__device__ __forceinline__ float bf_hi(unsigned u) { return __builtin_bit_cast(float, u & 0xffff0000u); }
__device__ __forceinline__ float wave_sum(float v) {
#pragma unroll
    for (int o = 1; o < 64; o <<= 1) v += __shfl_xor(v, o);
    return v;
}
#define LDS_WAIT() asm volatile("s_waitcnt lgkmcnt(0)" ::: "memory")

namespace pg8 {
constexpr int BM = 256, BK = 64, HALF = 128, HTB = HALF * BK * 2, NXCD = 8, WGM = 8;
__device__ __forceinline__ int lds_byte(int r, int c) { const int st = (r >> 4) * 2 + (c >> 5), rr = r & 15, cc = c & 31, ob = rr * 64 + cc * 2; return st * 1024 + (ob ^ (((ob >> 9) & 1) << 5)); }
__device__ __forceinline__ void stage_rc(int b, int& R, int& C) { const int st = b / 1024, sb = b % 1024, swz = sb ^ (((sb >> 9) & 1) << 5); R = (st >> 1) * 16 + swz / 64; C = (st & 1) * 32 + (swz % 64) / 2; }
__device__ __forceinline__ int perm32(int rho) { const int n = rho >> 4, i = rho & 15; return 8 * (i >> 2) + 4 * n + (i & 3); }

struct Unit { size_t aoff, boff, coff; };
struct Desc {
    const char* A; const char* B; unsigned lda, ldb; unsigned ahs, bhs; int nt, kmask, kshift; unsigned kpA, kpB;
    int nM, nN, nZ; unsigned a_z, a_m, b_z, b_m, b_n; unsigned c_z, c_m, c_n;
    bf16_t* C; unsigned ldc; int mode; float* aux;
    const float* rsc; const float* csc; int cperm;
};
__device__ __forceinline__ bool next_unit(const Desc& d, int i, int G, int c, Unit& u) {
    const int per = d.nM * d.nN, nwg = per * d.nZ; const long L = (long)i * G + c; if (L >= nwg) return false;
    int wgid = (int)L; { const int q = nwg / NXCD, r = nwg % NXCD, xcd = wgid % NXCD, off = wgid / NXCD; wgid = (xcd < r ? xcd * (q + 1) : r * (q + 1) + (xcd - r) * q) + off; }
    const int z = wgid / per, w = wgid - z * per;
    const int nig = WGM * d.nN, gid = w / nig, fm = gid * WGM, gsz = (d.nM - fm) < WGM ? (d.nM - fm) : WGM;
    const int pm = fm + ((w % nig) % gsz), pn = (w % nig) / gsz;
    u.aoff = (size_t)z * d.a_z + (size_t)pm * d.a_m;
    u.boff = (size_t)z * d.b_z + (size_t)pm * d.b_m + (size_t)pn * d.b_n;
    u.coff = (size_t)z * d.c_z + (size_t)pm * d.c_m + (size_t)pn * d.c_n;
    return true;
}
__device__ __forceinline__ f32x2 gelu_pk(f32x2 v) {
    const f32x2 av = __builtin_elementwise_abs(v), d = av * 0.2316418882f + 1.0f;
    f32x2 t; t.x = __builtin_amdgcn_rcpf(d.x); t.y = __builtin_amdgcn_rcpf(d.y);
    f32x2 q = t * 0.5307027145f + (-0.7265760135f); q = q * t + 0.7107068705f; q = q * t + (-0.142248368f); q = q * t + 0.127414796f; q = q * t;
    const f32x2 s = (v * v) * (-0.72134752044f);
    f32x2 e; e.x = __builtin_amdgcn_exp2f(s.x); e.y = __builtin_amdgcn_exp2f(s.y);
    const f32x2 m = v * (q * e), r = v - m;
    f32x2 o; o.x = v.x < 0.f ? m.x : r.x; o.y = v.y < 0.f ? m.y : r.y; return o;
}
__device__ __forceinline__ f32x4 gelu4(f32x4 v) { f32x2 a = gelu_pk((f32x2){v[0], v[1]}), b = gelu_pk((f32x2){v[2], v[3]}); return (f32x4){a.x, a.y, b.x, b.y}; }
__device__ __forceinline__ u32x4 pack8(f32x4 v0, f32x4 v1) { u32x4 w; w.x = cvt_pk_bf16(v0[0], v0[1]); w.y = cvt_pk_bf16(v0[2], v0[3]); w.z = cvt_pk_bf16(v1[0], v1[1]); w.w = cvt_pk_bf16(v1[2], v1[3]); return w; }

__device__ __forceinline__ void load_scales(float (&rr)[2][4], f32x4 (&cv)[2][2], const Desc& d, const Unit& u, int wr, int wc, int fr_, int fq_) {
    int fr = fr_, fq = fq_; asm volatile("" : "+v"(fr), "+v"(fq));
    const unsigned ldc = d.ldc;
    const float* rp = d.rsc + (u.coff / ldc) + wr * 64 + fr;
#pragma unroll
    for (int ai = 0; ai < 2; ++ai)
#pragma unroll
        for (int m = 0; m < 4; ++m) rr[ai][m] = d.rsc ? rp[ai * HALF + m * 16] : 1.0f;
    const int cb = (int)(u.coff % ldc) + wc * 32 + 8 * fq;
#pragma unroll
    for (int bj = 0; bj < 2; ++bj)
#pragma unroll
        for (int n = 0; n < 2; ++n) {
            f32x4 c1 = {1.f, 1.f, 1.f, 1.f};
            if (d.csc) {
                if (d.cperm) {
#pragma unroll
                    for (int j = 0; j < 4; ++j) { const int nn = cb + bj * HALF + 4 * n + j; c1[j] = d.csc[128 * (nn & 127) + (nn >> 7)]; }
                } else c1 = *(const f32x4*)(d.csc + cb + bj * HALF + 4 * n);
            }
            cv[bj][n] = c1;
        }
}
__device__ __forceinline__ void epilogue(f32x4 (&acc)[2][2][4][2], const Desc& d, const Unit& u, int wr, int wc, int fr_, int fq_, const float (&rr)[2][4], const f32x4 (&cv)[2][2]) {
    int fr = fr_, fq = fq_; asm volatile("" : "+v"(fr), "+v"(fq));
    const unsigned ldc = d.ldc;
    bf16_t* base = d.C + u.coff + (size_t)(wr * 64 + fr) * ldc + wc * 32 + 8 * fq;
    const int mode = d.mode & 7;
    if (mode == 4) {
#pragma unroll
        for (int m = 0; m < 4; ++m) {
            const int k1 = wr * 64 + m * 16 + fr;
            float tc[8], ts[8];
#pragma unroll
            for (int e = 0; e < 8; ++e) { const int s2 = wc * 32 + 8 * fq + e; const float tr = (float)((k1 * s2) & 16383) * (1.0f / 16384.0f); tc[e] = __builtin_amdgcn_cosf(tr); ts[e] = __builtin_amdgcn_sinf(tr); }
            bf16_t* r0 = base + (size_t)(m * 16) * ldc; bf16_t* r1 = r0 + (size_t)HALF * ldc;
#pragma unroll
            for (int bj = 0; bj < 2; ++bj) {
                f32x4 yr0 = acc[0][bj][m][0], yr1 = acc[0][bj][m][1], yi0 = acc[1][bj][m][0], yi1 = acc[1][bj][m][1], a0, a1, b0, b1;
#pragma unroll
                for (int j = 0; j < 4; ++j) { a0[j] = yr0[j] * tc[j] + yi0[j] * ts[j]; b0[j] = yi0[j] * tc[j] - yr0[j] * ts[j];
                                              a1[j] = yr1[j] * tc[4 + j] + yi1[j] * ts[4 + j]; b1[j] = yi1[j] * tc[4 + j] - yr1[j] * ts[4 + j]; }
                *(u32x4*)(r0 + bj * HALF) = pack8(a0, a1); *(u32x4*)(r1 + bj * HALF) = pack8(b0, b1);
            }
        }
        return;
    }
    float cs[2][2][4];
    if (mode == 3) {
#pragma unroll
        for (int bj = 0; bj < 2; ++bj)
#pragma unroll
            for (int n = 0; n < 2; ++n)
#pragma unroll
                for (int j = 0; j < 4; ++j) cs[bj][n][j] = 0.f;
    }
#pragma unroll
    for (int ai = 0; ai < 2; ++ai) {
        if (mode == 5 && ai == 1) break;
#pragma unroll
        for (int m = 0; m < 4; ++m) {
            bf16_t* rowp = base + (size_t)(ai * HALF + m * 16) * ldc;
#pragma unroll
            for (int bj = 0; bj < 2; ++bj) {
                f32x4 v0 = acc[ai][bj][m][0] * (cv[bj][0] * rr[ai][m]), v1 = acc[ai][bj][m][1] * (cv[bj][1] * rr[ai][m]);
                if (mode == 1 || mode == 3) { v0 = gelu4(v0); v1 = gelu4(v1); }
                if (mode == 2) {
#pragma unroll
                    for (int j = 0; j < 4; ++j) { const float a = fmaxf(v0[j], 0.f), b = fmaxf(v1[j], 0.f); v0[j] = a * a; v1[j] = b * b; }
                }
                if (mode == 3) {
#pragma unroll
                    for (int j = 0; j < 4; ++j) { cs[bj][0][j] += v0[j] * v0[j]; cs[bj][1][j] += v1[j] * v1[j]; }
                }
                if (!(d.mode & 8) || v0[0] == 12345.678f) *(u32x4*)(rowp + bj * HALF) = pack8(v0, v1);
            }
        }
    }
    if (mode == 3) {
        float* sq = d.aux + (size_t)((u.coff / ldc) / 256 * 2 + wr) * NTOK + (u.coff % ldc) + wc * 32 + 8 * fq;
#pragma unroll
        for (int bj = 0; bj < 2; ++bj)
#pragma unroll
            for (int n = 0; n < 2; ++n)
#pragma unroll
                for (int j = 0; j < 4; ++j) {
                    float s = cs[bj][n][j];
                    s += __shfl_xor(s, 1); s += __shfl_xor(s, 2); s += __shfl_xor(s, 4); s += __shfl_xor(s, 8);
                    if (fr == 0) sq[bj * HALF + 4 * n + j] = s;
                }
    }
}

__device__ __forceinline__ void gemm_phase(LAS unsigned char* lds, const Desc& g, int G, int c) {
    int tid = threadIdx.x; asm volatile("" : "+v"(tid));
    const int wid = __builtin_amdgcn_readfirstlane(tid >> 6), lane = tid & 63, wr = wid >> 2, wc = wid & 3, fr = lane & 15, fq = lane >> 4;
    const int nt = g.nt, kmask = g.kmask, kshift = g.kshift; const unsigned kpA = g.kpA, kpB = g.kpB;
    unsigned voffA[2], voffB[2];
#pragma unroll
    for (int i = 0; i < 2; ++i) { int R, C; stage_rc(tid * 16 + i * 8192, R, C); const int Rb = (R & ~31) + perm32(R & 31);
        voffA[i] = (unsigned)(R * g.lda + C) * 2u; voffB[i] = (unsigned)(Rb * g.ldb + C) * 2u; }
    const unsigned ahs = g.ahs, bhs = g.bhs;
    const unsigned ldsw = (unsigned)wid * 1024u;
    const int aoff = lds_byte(wr * 64 + fr, fq * 8), boff = lds_byte(wc * 32 + fr, fq * 8);
#define KOA(t) ((size_t)((t) & kmask) * 128u + (size_t)((t) >> kshift) * kpA)
#define KOB(t) ((size_t)((t) & kmask) * 128u + (size_t)((t) >> kshift) * kpB)
#define PG8_SA(b, h) (((b) * 2 + (h)) * HTB)
#define PG8_SB(b, h) ((4 + (b) * 2 + (h)) * HTB)
#define PG8_STAGE(bufoff, gbase, voff) do { _Pragma("unroll") for (int _i = 0; _i < 2; ++_i) \
        __builtin_amdgcn_global_load_lds((const unsigned*)((const char*)(gbase) + (voff)[_i]), (LAS unsigned*)(lds + (bufoff) + ldsw + _i * 8192), 16, 0, 0); } while (0)
#define PG8_LDA(dst, b, h) do { _Pragma("unroll") for (int m = 0; m < 4; ++m) _Pragma("unroll") for (int k = 0; k < 2; ++k) dst[m][k] = *(const LAS bf16x8*)(lds + PG8_SA(b, h) + aoff + m * 2048 + k * 1024); } while (0)
#define PG8_LDB(dst, b, h) do { _Pragma("unroll") for (int n = 0; n < 2; ++n) _Pragma("unroll") for (int k = 0; k < 2; ++k) dst[n][k] = *(const LAS bf16x8*)(lds + PG8_SB(b, h) + boff + n * 2048 + k * 1024); } while (0)
#define PG8_MMA(ai, bj, At, Bt) do { __builtin_amdgcn_s_setprio(1); _Pragma("unroll") for (int m = 0; m < 4; ++m) _Pragma("unroll") for (int n = 0; n < 2; ++n) _Pragma("unroll") for (int k = 0; k < 2; ++k) \
        acc[ai][bj][m][n] = __builtin_amdgcn_mfma_f32_16x16x32_bf16(Bt[n][k], At[m][k], acc[ai][bj][m][n], 0, 0, 0); __builtin_amdgcn_s_setprio(0); } while (0)
#define PG8_WAIT_V(n) asm volatile("s_waitcnt vmcnt(" #n ")" ::: "memory")
#define PG8_WAIT_L(n) asm volatile("s_waitcnt lgkmcnt(" #n ")" ::: "memory")
#define PG8_BAR __builtin_amdgcn_s_barrier()
#define PG8_SCHED __builtin_amdgcn_sched_barrier(0)
    Unit cur, nxt; int ui = 0;
    if (!next_unit(g, 0, G, c, cur)) return;
    f32x4 acc[2][2][4][2];
#pragma unroll
    for (int a = 0; a < 2; ++a)
#pragma unroll
        for (int b = 0; b < 2; ++b)
#pragma unroll
            for (int m = 0; m < 4; ++m)
#pragma unroll
                for (int n = 0; n < 2; ++n) acc[a][b][m][n] = (f32x4){0.f, 0.f, 0.f, 0.f};
    bf16x8 At[4][2], B0[2][2], B1[2][2];
    const char* cA = g.A + cur.aoff; const char* cB = g.B + cur.boff;
    {
        const size_t k1a = KOA(1), k1b = KOB(1);
        PG8_STAGE(PG8_SB(0, 0), cB, voffB); PG8_STAGE(PG8_SB(0, 1), cB + bhs, voffB); PG8_STAGE(PG8_SA(0, 0), cA, voffA); PG8_STAGE(PG8_SA(0, 1), cA + ahs, voffA);
        if (wr == 1) PG8_BAR;
        PG8_WAIT_V(2); PG8_BAR;
        PG8_STAGE(PG8_SB(1, 0), cB + k1b, voffB); PG8_STAGE(PG8_SA(1, 0), cA + k1a, voffA); PG8_STAGE(PG8_SB(1, 1), cB + bhs + k1b, voffB);
        PG8_WAIT_V(6); PG8_BAR;
    }
    float rr[2][4]; f32x4 cv[2][2];
    for (;;) {
        const bool has_next = next_unit(g, ui + 1, G, c, nxt);
        load_scales(rr, cv, g, cur, wr, wc, fr, fq);
        const char* nA = has_next ? g.A + nxt.aoff : cA; const char* nB = has_next ? g.B + nxt.boff : cB;
        for (int t = 0; t < nt; t += 2) {
            const bool last = (t == nt - 2);
            const char* a1 = cA + KOA(t + 1);
            const char* a2 = last ? nA : cA + KOA(t + 2); const char* b2 = last ? nB : cB + KOB(t + 2);
            const char* a3 = last ? nA + KOA(1) : cA + KOA(t + 3); const char* b3 = last ? nB + KOB(1) : cB + KOB(t + 3);
            PG8_LDB(B0, 0, 0); PG8_LDB(B1, 0, 1); PG8_SCHED; PG8_LDA(At, 0, 0); PG8_STAGE(PG8_SA(1, 1), a1 + ahs, voffA);
            PG8_WAIT_V(8); PG8_WAIT_L(0); PG8_BAR; PG8_MMA(0, 0, At, B0); PG8_MMA(0, 1, At, B1); PG8_BAR; PG8_SCHED;
            PG8_LDA(At, 0, 1); PG8_STAGE(PG8_SB(0, 0), b2, voffB); PG8_STAGE(PG8_SB(0, 1), b2 + bhs, voffB); PG8_STAGE(PG8_SA(0, 0), a2, voffA);
            PG8_WAIT_V(8); PG8_WAIT_L(0); PG8_BAR; PG8_MMA(1, 0, At, B0); PG8_MMA(1, 1, At, B1); PG8_BAR; PG8_SCHED;
            PG8_LDB(B0, 1, 0); PG8_LDB(B1, 1, 1); PG8_SCHED; PG8_LDA(At, 1, 0); PG8_STAGE(PG8_SA(0, 1), a2 + ahs, voffA);
            PG8_WAIT_V(8); PG8_WAIT_L(0); PG8_BAR; PG8_MMA(0, 0, At, B0); PG8_MMA(0, 1, At, B1); PG8_BAR; PG8_SCHED;
            PG8_LDA(At, 1, 1); PG8_STAGE(PG8_SB(1, 0), b3, voffB); PG8_STAGE(PG8_SB(1, 1), b3 + bhs, voffB); PG8_STAGE(PG8_SA(1, 0), a3, voffA);
            PG8_WAIT_V(8); PG8_WAIT_L(0); PG8_BAR; PG8_MMA(1, 0, At, B0); PG8_MMA(1, 1, At, B1); PG8_BAR; PG8_SCHED;
        }
        if (wr == 0) PG8_BAR;
        epilogue(acc, g, cur, wr, wc, fr, fq, rr, cv);
        if (!has_next) break;
#pragma unroll
        for (int a = 0; a < 2; ++a)
#pragma unroll
            for (int b = 0; b < 2; ++b)
#pragma unroll
                for (int m = 0; m < 4; ++m)
#pragma unroll
                    for (int n = 0; n < 2; ++n) acc[a][b][m][n] = (f32x4){0.f, 0.f, 0.f, 0.f};
        cur = nxt; cA = nA; cB = nB; ++ui;
        if (wr == 1) PG8_BAR;
    }
    PG8_WAIT_V(0);
    PG8_BAR;
#undef KOA
#undef KOB
#undef PG8_SA
#undef PG8_SB
#undef PG8_STAGE
#undef PG8_LDA
#undef PG8_LDB
#undef PG8_MMA
#undef PG8_WAIT_V
#undef PG8_WAIT_L
#undef PG8_BAR
#undef PG8_SCHED
}
}

namespace att {
constexpr int D = 128, NW = 8, QBLK = 32, KVBLK = 64;
constexpr float SCALE = 0.088388347648318440f;
constexpr float THR = 8.f;
constexpr int LDQ = QKVW, LDK = QKVW, LDO = DM;
constexpr size_t SHM_V = KVBLK * D * 2, SHM_K = KVBLK * D * 2;
#define KSWZ(row, colB) ((row) * 256 + ((colB) ^ (((row) & 7) << 4)))
#define SBAR() __builtin_amdgcn_sched_barrier(0)
__device__ __forceinline__ int crow(int r, int hi) { return (r & 3) + 8 * (r >> 2) + 4 * hi; }
__device__ __forceinline__ unsigned cvtpk(float lo, float hi) { unsigned r; asm volatile("v_cvt_pk_bf16_f32 %0, %1, %2" : "=v"(r) : "v"(lo), "v"(hi)); return r; }
__device__ __forceinline__ void partialSM(f32x16& p0, f32x16& p1, float& m_reg, float& mn, float& alpha) {
    constexpr float C = SCALE * 1.4426950408889634f;
    float pmax = p0[0];
#pragma unroll
    for (int r = 1; r < 16; ++r) pmax = fmaxf(pmax, p0[r]);
#pragma unroll
    for (int r = 0; r < 16; ++r) pmax = fmaxf(pmax, p1[r]);
    { auto rr = __builtin_amdgcn_permlane32_swap(__float_as_uint(pmax), __float_as_uint(pmax), false, false);
      pmax = fmaxf(__uint_as_float(rr[0]), __uint_as_float(rr[1])); }
    if (__builtin_expect(__all(pmax - m_reg <= THR / SCALE), 1)) { mn = m_reg; alpha = 1.f; }
    else { mn = fmaxf(m_reg, pmax); alpha = __builtin_amdgcn_exp2f((m_reg - mn) * C); m_reg = mn; }
    float mnC = -mn * C;
#pragma unroll
    for (int r = 0; r < 16; ++r) p0[r] = fmaf(p0[r], C, mnC);
#pragma unroll
    for (int r = 0; r < 16; ++r) p1[r] = fmaf(p1[r], C, mnC);
#pragma unroll
    for (int r = 0; r < 16; ++r) p0[r] = __builtin_amdgcn_exp2f(p0[r]);
}
__device__ __forceinline__ void finishSM(f32x16& p0, f32x16& p1, float alpha, float& l_reg, bf16x8& pa0, bf16x8& pa1, bf16x8& pa2, bf16x8& pa3) {
#pragma unroll
    for (int r = 0; r < 16; ++r) p1[r] = __builtin_amdgcn_exp2f(p1[r]);
    float ps = 0;
#pragma unroll
    for (int r = 0; r < 16; ++r) ps += p0[r];
#pragma unroll
    for (int r = 0; r < 16; ++r) ps += p1[r];
    { auto rr = __builtin_amdgcn_permlane32_swap(__float_as_uint(ps), __float_as_uint(ps), false, false);
      ps = __uint_as_float(rr[0]) + __uint_as_float(rr[1]); }
    l_reg = l_reg * alpha + ps;
#define PK4(P, BASE, OUT) do { unsigned a0 = cvtpk(P[BASE + 0], P[BASE + 1]), a1 = cvtpk(P[BASE + 2], P[BASE + 3]);   \
    unsigned b0 = cvtpk(P[BASE + 4], P[BASE + 5]), b1 = cvtpk(P[BASE + 6], P[BASE + 7]);                              \
    auto r0 = __builtin_amdgcn_permlane32_swap(a0, b0, false, false); auto r1 = __builtin_amdgcn_permlane32_swap(a1, b1, false, false); \
    u32x4 w = {r0[0], r1[0], r0[1], r1[1]}; OUT = *reinterpret_cast<bf16x8*>(&w); } while (0)
    PK4(p0, 0, pa0); PK4(p0, 8, pa1); PK4(p1, 0, pa2); PK4(p1, 8, pa3);
#undef PK4
}
__device__ __forceinline__ void qkt(f32x16& p0, f32x16& p1, const bf16_t* Ks, const bf16x8* qr, int r32, int hi) {
    p0 = f32x16{}; p1 = f32x16{};
#pragma unroll
    for (int d0 = 0; d0 < 8; ++d0) { int cb = (d0 * 16 + hi * 8) * 2;
        bf16x8 b0 = *reinterpret_cast<const bf16x8*>((const char*)Ks + KSWZ(r32, cb));
        bf16x8 b1 = *reinterpret_cast<const bf16x8*>((const char*)Ks + KSWZ(32 + r32, cb));
        p0 = __builtin_amdgcn_mfma_f32_32x32x16_bf16(b0, qr[d0], p0, 0, 0, 0);
        p1 = __builtin_amdgcn_mfma_f32_32x32x16_bf16(b1, qr[d0], p1, 0, 0, 0); }
}
__device__ __forceinline__ int v_st(int k, int c) { const int kk = (k & ~0xC) | ((k & 4) << 1) | ((k & 8) >> 1); return ((kk >> 3) * 4 + (c >> 5)) * 512 + ((kk & 7) * 32 + (c & 31)) * 2; }
__device__ __forceinline__ int v_rd_base(int lane) { return ((lane & 3) << 3) | (((lane >> 2) & 3) << 6) | (((lane >> 4) & 1) << 5) | (((lane >> 5) & 1) << 8); }
constexpr int v_rd_off(int d0, int ks, int half) { return d0 * 512 + ks * 4096 + half * 2048; }
template <int OFF> __device__ __forceinline__ s16x4 tr_read(int vb) {
    s16x4 r; asm volatile("ds_read_b64_tr_b16 %0, %1 offset:%2" : "=&v"(r) : "v"(vb), "i"(OFF) : "memory"); return r;
}
template <int D0> __device__ __forceinline__ void pv_one(f32x16& od, int vb, bf16x8 pa0, bf16x8 pa1, bf16x8 pa2, bf16x8 pa3) {
    const s16x4 l0 = tr_read<v_rd_off(D0, 0, 0)>(vb), h0 = tr_read<v_rd_off(D0, 0, 1)>(vb), l1 = tr_read<v_rd_off(D0, 1, 0)>(vb), h1 = tr_read<v_rd_off(D0, 1, 1)>(vb);
    const s16x4 l2 = tr_read<v_rd_off(D0, 2, 0)>(vb), h2 = tr_read<v_rd_off(D0, 2, 1)>(vb), l3 = tr_read<v_rd_off(D0, 3, 0)>(vb), h3 = tr_read<v_rd_off(D0, 3, 1)>(vb);
    asm volatile("s_waitcnt lgkmcnt(0)" ::: "memory"); SBAR();
#define PK(L, H) (bf16x8){L[0], L[1], L[2], L[3], H[0], H[1], H[2], H[3]}
    od = __builtin_amdgcn_mfma_f32_32x32x16_bf16(pa0, PK(l0, h0), od, 0, 0, 0);
    od = __builtin_amdgcn_mfma_f32_32x32x16_bf16(pa1, PK(l1, h1), od, 0, 0, 0);
    od = __builtin_amdgcn_mfma_f32_32x32x16_bf16(pa2, PK(l2, h2), od, 0, 0, 0);
    od = __builtin_amdgcn_mfma_f32_32x32x16_bf16(pa3, PK(l3, h3), od, 0, 0, 0);
#undef PK
}
__device__ __forceinline__ void pv_d0(f32x16* o, int vb, bf16x8 pa0, bf16x8 pa1, bf16x8 pa2, bf16x8 pa3) {
    pv_one<0>(o[0], vb, pa0, pa1, pa2, pa3); pv_one<1>(o[1], vb, pa0, pa1, pa2, pa3); pv_one<2>(o[2], vb, pa0, pa1, pa2, pa3); pv_one<3>(o[3], vb, pa0, pa1, pa2, pa3);
}
__device__ __forceinline__ void attn_dense_body(const bf16_t* __restrict__ Qb, const bf16_t* __restrict__ Kh, const bf16_t* __restrict__ Vh,
                                                bf16_t* __restrict__ Ob, int seq, char* lds) {
    int tid = threadIdx.x; asm volatile("" : "+v"(tid));
    const int wid = tid >> 6, lane = tid & 63, r32 = lane & 31, hi = lane >> 5;
    bf16_t* V_lds = (bf16_t*)lds; bf16_t* K_lds = (bf16_t*)(lds + 2 * SHM_V);
    float* ws = (float*)(lds + 2 * SHM_V + 2 * SHM_K) + wid * 64; float* li_l = ws; float* al_l = ws + 32;
    float m_reg = -1e30f, l_reg = 0; f32x16 o[4] = {}; bf16x8 qr[8];
    const bf16_t* Qw = Qb + (long)(wid * QBLK + r32) * LDQ + hi * 8;
#pragma unroll
    for (int d0 = 0; d0 < 8; ++d0) qr[d0] = *reinterpret_cast<const bf16x8*>(Qw + d0 * 16);
    const int sr = tid >> 4, sc = (tid & 15) * 8, vst0 = v_st(sr, sc), vst1 = v_st(32 + sr, sc);
    const int vb0 = (int)(uintptr_t)V_lds + v_rd_base(lane);
    struct { bf16x8 vs0, vs1, ks0, ks1; } sr_[2];
#define LD8(p) (*reinterpret_cast<const bf16x8*>(p))
#define SLOAD(i, k0) do { sr_[i].vs0 = LD8(&Vh[(long)((k0) + sr) * LDK + sc]); sr_[i].vs1 = LD8(&Vh[(long)((k0) + 32 + sr) * LDK + sc]); \
    sr_[i].ks0 = LD8(&Kh[(long)((k0) + sr) * LDK + sc]); sr_[i].ks1 = LD8(&Kh[(long)((k0) + 32 + sr) * LDK + sc]); } while (0)
#define SWRITE(b, i) do { *(bf16x8*)((char*)V_lds + (b) * SHM_V + vst0) = sr_[i].vs0;          \
    *(bf16x8*)((char*)V_lds + (b) * SHM_V + vst1) = sr_[i].vs1; int kc = sc * 2;               \
    *(bf16x8*)((char*)K_lds + (b) * SHM_K + KSWZ(sr, kc)) = sr_[i].ks0;                       \
    *(bf16x8*)((char*)K_lds + (b) * SHM_K + KSWZ(32 + sr, kc)) = sr_[i].ks1; } while (0)
#define SWAIT() asm volatile("s_waitcnt vmcnt(4)" ::: "memory")
#define RESC(a) do { if (__any((a) < 1.f)) { if (hi == 0) al_l[r32] = (a); asm volatile("s_waitcnt lgkmcnt(0)" ::: "memory"); \
    _Pragma("unroll") for (int d = 0; d < 4; ++d) _Pragma("unroll") for (int r = 0; r < 16; ++r) o[d][r] *= al_l[crow(r, hi)]; } } while (0)
    f32x16 pA0, pA1, pB0, pB1; float mnA, mnB, alA, alB; bf16x8 pa0, pa1, pa2, pa3; const int NT = seq / KVBLK;
    constexpr int SE = 0, SO = 1;
    SLOAD(SE, 0); asm volatile("s_waitcnt vmcnt(0)" ::: "memory"); SWRITE(0, SE); __syncthreads();
    qkt(pA0, pA1, K_lds, qr, r32, hi); partialSM(pA0, pA1, m_reg, mnA, alA);
    SLOAD(SO, KVBLK); if (2 < NT) SLOAD(SE, 2 * KVBLK);
    SWAIT(); SWRITE(1, SO); __syncthreads();
    for (int j = 1; j + 1 < NT; j += 2) {
        SBAR(); qkt(pB0, pB1, (bf16_t*)((char*)K_lds + SHM_K), qr, r32, hi);
        finishSM(pA0, pA1, alA, l_reg, pa0, pa1, pa2, pa3); SBAR();
        SLOAD(SO, (j + 2) * KVBLK); SBAR();
        pv_d0(o, vb0, pa0, pa1, pa2, pa3); partialSM(pB0, pB1, m_reg, mnB, alB);
        __syncthreads(); SWAIT(); SWRITE(0, SE);
        RESC(alB); __syncthreads();
        SBAR(); qkt(pA0, pA1, K_lds, qr, r32, hi);
        finishSM(pB0, pB1, alB, l_reg, pa0, pa1, pa2, pa3); SBAR();
        if (j + 3 < NT) SLOAD(SE, (j + 3) * KVBLK); SBAR();
        pv_d0(o, vb0 + (int)SHM_V, pa0, pa1, pa2, pa3); partialSM(pA0, pA1, m_reg, mnA, alA);
        __syncthreads(); SWAIT(); SWRITE(1, SO);
        RESC(alA); __syncthreads();
    }
    SBAR(); qkt(pB0, pB1, (bf16_t*)((char*)K_lds + SHM_K), qr, r32, hi);
    finishSM(pA0, pA1, alA, l_reg, pa0, pa1, pa2, pa3); SBAR();
    pv_d0(o, vb0, pa0, pa1, pa2, pa3); partialSM(pB0, pB1, m_reg, mnB, alB);
    __syncthreads(); RESC(alB);
    finishSM(pB0, pB1, alB, l_reg, pa0, pa1, pa2, pa3); SBAR();
    pv_d0(o, vb0 + (int)SHM_V, pa0, pa1, pa2, pa3);
    if (hi == 0) li_l[r32] = l_reg; asm volatile("s_waitcnt lgkmcnt(0)" ::: "memory");
    float rli[16];
#pragma unroll
    for (int r = 0; r < 16; ++r) rli[r] = __builtin_amdgcn_rcpf(li_l[crow(r, hi)]);
    bf16_t* Ow = Ob + (long)(wid * QBLK) * LDO;
#pragma unroll
    for (int r = 0; r < 16; ++r) { int orow = crow(r, hi);
#pragma unroll
        for (int d0 = 0; d0 < 4; ++d0) Ow[(long)orow * LDO + d0 * 32 + r32] = (bf16_t)f2bf(o[d0][r] * rli[r]); }
#undef LD8
#undef SLOAD
#undef SWRITE
#undef SWAIT
#undef RESC
}
}

#define XB_TMO      128
#define XB_XCNT(j)  (256  + 64 * (j))
#define XB_XSUB(j)  (1280 + 64 * (j))
#define XB_XGEN(j)  (2304 + 64 * (j))
#define XB_TOP      3328
#define XB_TOPGEN   3392
#define XCD_BAR_WORDS 3456
#define XB_SPIN_CAP (1u << 22)
__device__ __forceinline__ unsigned xb_ld(unsigned* p)              { return __hip_atomic_load(p, __ATOMIC_RELAXED, __HIP_MEMORY_SCOPE_AGENT); }
__device__ __forceinline__ unsigned xb_add(unsigned* p, unsigned v) { return __hip_atomic_fetch_add(p, v, __ATOMIC_RELAXED, __HIP_MEMORY_SCOPE_AGENT); }
__device__ __forceinline__ unsigned xb_xcc_id() { return (unsigned)__builtin_amdgcn_s_getreg((3 << 11) | 20) & 0xFu; }
#define XB_SPIN(cond, bar) do { unsigned _sp = 0; while (cond) { __builtin_amdgcn_s_sleep(1); \
    if ((++_sp & 255u) == 0u) { if (xb_ld(&(bar)[XB_TMO])) break; if (_sp > XB_SPIN_CAP) { atomicAdd(&(bar)[XB_TMO], 1u); break; } } } } while (0)
struct XcdBarrier { unsigned* bar; unsigned x; volatile LAS unsigned* st; };
__device__ __forceinline__ XcdBarrier xcd_barrier_post(unsigned* bar, volatile LAS unsigned* st) {
    XcdBarrier b; b.bar = bar; b.x = xb_xcc_id(); b.st = st;
    if (threadIdx.x == 0) (void)xb_add(&bar[XB_XCNT(b.x)], 1u);
    return b;
}
__device__ __forceinline__ void xcd_barrier_complete(unsigned* bar, unsigned x, unsigned& nloc, unsigned& nx) {
    const unsigned G = gridDim.x * gridDim.y * gridDim.z;
    unsigned sum, cnt, mine, sp = 0u;
    for (;;) {
        sum = 0u; cnt = 0u; mine = 0u;
#pragma unroll
        for (unsigned j = 0; j < 16; ++j) { const unsigned c = xb_ld(&bar[XB_XCNT(j)]); sum += c; cnt += (c > 0u) ? 1u : 0u; mine = (j == x) ? c : mine; }
        if (sum == G) break;
        __builtin_amdgcn_s_sleep(1);
        if ((++sp & 255u) == 0u) { if (xb_ld(&bar[XB_TMO])) break; if (sp > XB_SPIN_CAP) { atomicAdd(&bar[XB_TMO], 1u); break; } }
    }
    nloc = mine > 0u ? mine : 1u; nx = cnt > 0u ? cnt : 1u;
}
__device__ __forceinline__ void xcd_barrier(const XcdBarrier& b) {
    asm volatile("s_waitcnt vmcnt(0)" ::: "memory");
    __syncthreads();
    if (threadIdx.x == 0) {
        unsigned* bar = b.bar;
        __builtin_amdgcn_s_waitcnt(0);
        unsigned nloc = b.st[0], nx = b.st[1];
        if (nloc == 0u) { xcd_barrier_complete(bar, b.x, nloc, nx); b.st[0] = nloc; b.st[1] = nx; }
        const unsigned old = xb_add(&bar[XB_XSUB(b.x)], 1u);
        const unsigned gen = old / nloc;
        if (old + 1u == (gen + 1u) * nloc) {
            __builtin_amdgcn_fence(__ATOMIC_RELEASE, "agent");
            asm volatile("s_waitcnt vmcnt(0)" ::: "memory");
            const unsigned og = xb_add(&bar[XB_TOP], 1u);
            const unsigned tg = og / nx;
            if (og + 1u == (tg + 1u) * nx) xb_add(&bar[XB_TOPGEN], 1u);
            else XB_SPIN(xb_ld(&bar[XB_TOPGEN]) == tg, bar);
            __builtin_amdgcn_fence(__ATOMIC_ACQUIRE, "agent");
            xb_add(&bar[XB_XGEN(b.x)], 1u);
            asm volatile("s_waitcnt vmcnt(0)" ::: "memory");
        } else {
            XB_SPIN(xb_ld(&bar[XB_XGEN(b.x)]) == gen, bar);
            __builtin_amdgcn_fence(__ATOMIC_ACQUIRE, "agent");
            asm volatile("s_waitcnt vmcnt(0)" ::: "memory");
        }
    }
    __syncthreads();
}

struct Params { const float* in[15]; float* out; unsigned char* ws; int nsteps; int pad; int steps[128]; };
enum Kind { K_INIT = 0, K_GU, K_GV, K_SG, K_GO, K_EA, K_M1, K_M2, K_EB, K_QKV, K_QKN, K_ATT, K_WO, K_CDS, K_CDP, K_F1, K_PD, K_F3, K_CO, K_COS };
enum In { I_XP = 0, I_XS, I_NG, I_AWIN, I_AVN, I_AWS, I_ABS, I_AWOUT, I_BQKV, I_BQN, I_BKN, I_BWO, I_CWOUT, I_MWIN, I_MWOUT };

__device__ __forceinline__ void transpose_item(const float* W, int K, int N, bf16_t* WT, LAS float* scr, int item, int lane, const float* gk) {
    const int nblk = N / 32, kb = item / nblk, nb = item % nblk, k0 = 64 * kb, n0 = 32 * nb;
#pragma unroll 8
    for (int i = 0; i < 32; ++i) { const int kk = 2 * i + (lane >> 5); scr[kk * 33 + (lane & 31)] = W[(size_t)(k0 + kk) * N + n0 + (lane & 31)]; }
    LDS_WAIT(); asm volatile("" ::: "memory");
    const int c = lane & 7;
    const f32x4 one4 = {1.f, 1.f, 1.f, 1.f};
    const f32x4 g0 = gk ? *(const f32x4*)(gk + k0 + 8 * c) : one4, g1 = gk ? *(const f32x4*)(gk + k0 + 8 * c + 4) : one4;
#pragma unroll
    for (int j = 0; j < 4; ++j) { const int n = (lane >> 3) + 8 * j; const LAS float* s = scr + (8 * c) * 33 + n;
        u32x4 o; o.x = pk2(s[0 * 33] * g0[0], s[1 * 33] * g0[1]); o.y = pk2(s[2 * 33] * g0[2], s[3 * 33] * g0[3]); o.z = pk2(s[4 * 33] * g1[0], s[5 * 33] * g1[1]); o.w = pk2(s[6 * 33] * g1[2], s[7 * 33] * g1[3]);
        *(u32x4*)(WT + (size_t)(n0 + n) * K + k0 + 8 * c) = o; }
    LDS_WAIT(); asm volatile("" ::: "memory");
}
__device__ __forceinline__ void transpose_job(const float* W, int K, int N, bf16_t* WT, LAS float* scr, int gw, int NGW, int lane_, const float* gk) {
    int lane = lane_; asm volatile("" : "+v"(lane));
    const int nitems = (K / 64) * (N / 32);
    for (int it = gw; it < nitems; it += NGW) transpose_item(W, K, N, WT, scr, it, lane, gk);
}
__device__ __forceinline__ void convert_layer(const Params& p, int L, LAS float* scr, int gw, int NGW, int lane) {
    unsigned char* ws = p.ws; const int m = L % 3, j = L / 3;
    const float* ngL = p.in[I_NG] + (size_t)L * 4 * DM;
    if (m == 0) {
        transpose_job(p.in[I_AWIN] + (size_t)j * DM * 2 * AW, DM, 2 * AW, (bf16_t*)(ws + WS_WMIX), scr, gw, NGW, lane, ngL);
        transpose_job(p.in[I_AWOUT] + (size_t)j * AW * DM, AW, DM, (bf16_t*)(ws + WS_WMIX2_A), scr, gw, NGW, lane, nullptr);
    } else if (m == 1) {
        transpose_job(p.in[I_BQKV] + (size_t)j * DM * QKVW, DM, QKVW, (bf16_t*)(ws + WS_WMIX), scr, gw, NGW, lane, ngL);
        transpose_job(p.in[I_BWO] + (size_t)j * DM * DM, DM, DM, (bf16_t*)(ws + WS_WMIX2_B), scr, gw, NGW, lane, nullptr);
    } else {
        transpose_job(p.in[I_CWOUT] + (size_t)j * DM * DM, DM, DM, (bf16_t*)(ws + WS_WMIX), scr, gw, NGW, lane, nullptr);
    }
    transpose_job(p.in[I_MWIN] + (size_t)L * DM * DFF, DM, DFF, (bf16_t*)(ws + WS_WMI), scr, gw, NGW, lane, ngL + 2 * DM);
    transpose_job(p.in[I_MWOUT] + (size_t)L * DFF * DM, DFF, DM, (bf16_t*)(ws + WS_WMO), scr, gw, NGW, lane, nullptr);
}

__device__ __forceinline__ void rows_phase(const float* xin_p, const float* xin_s, bf16_t* XB, const bf16_t* y, const float* ga, float* rs, float* fout,
                                           int gw, int NGW, int lane_) {
    int lane = lane_; asm volatile("" : "+v"(lane));
    if (xin_p) {
        for (int row = gw; row < NTOK; row += NGW) {
            const float* xr = row < NPROMPT ? xin_p + (size_t)row * DM : xin_s + (size_t)(row - NPROMPT) * DM;
            f32x4 v[4];
#pragma unroll
            for (int j = 0; j < 4; ++j) v[j] = *(const f32x4*)(xr + 4 * lane + 256 * j);
            bf16_t* xo = XB + (size_t)row * DM; float s2 = 0.f;
#pragma unroll
            for (int j = 0; j < 4; ++j) { u32x2 w; w.x = pk2(v[j][0], v[j][1]); w.y = pk2(v[j][2], v[j][3]); *(u32x2*)(xo + 4 * lane + 256 * j) = w;
                const float a = bf_lo(w.x), b = bf_hi(w.x), c = bf_lo(w.y), d = bf_hi(w.y); s2 += (a * a + b * b) + (c * c + d * d); }
            const float r2 = 1.0f / sqrtf(wave_sum(s2) * (1.0f / DM) + EPS);
            if (lane == 0) rs[row] = r2;
        }
        return;
    }
    f32x4 A[4];
#pragma unroll
    for (int j = 0; j < 4; ++j) A[j] = *(const f32x4*)(ga + 4 * lane + 256 * j);
    u32x2 xa[4], ya[4], xb[4], yb[4];
    if (gw < NTOK) {
#pragma unroll
        for (int j = 0; j < 4; ++j) { xa[j] = *(const u32x2*)(XB + (size_t)gw * DM + 4 * lane + 256 * j); ya[j] = *(const u32x2*)(y + (size_t)gw * DM + 4 * lane + 256 * j); }
    }
    for (int row = gw; row < NTOK; row += NGW) {
        const int nrow = row + NGW < NTOK ? row + NGW : row;
#pragma unroll
        for (int j = 0; j < 4; ++j) { xb[j] = *(const u32x2*)(XB + (size_t)nrow * DM + 4 * lane + 256 * j); yb[j] = *(const u32x2*)(y + (size_t)nrow * DM + 4 * lane + 256 * j); }
        f32x4 v[4], yy[4]; float s = 0.f;
#pragma unroll
        for (int j = 0; j < 4; ++j) { v[j] = (f32x4){bf_lo(xa[j].x), bf_hi(xa[j].x), bf_lo(xa[j].y), bf_hi(xa[j].y)};
            yy[j] = (f32x4){bf_lo(ya[j].x), bf_hi(ya[j].x), bf_lo(ya[j].y), bf_hi(ya[j].y)};
            s += (yy[j][0] * yy[j][0] + yy[j][1] * yy[j][1]) + (yy[j][2] * yy[j][2] + yy[j][3] * yy[j][3]); }
        const float r = 1.0f / sqrtf(wave_sum(s) * (1.0f / DM) + EPS);
#pragma unroll
        for (int j = 0; j < 4; ++j) v[j] = v[j] + (yy[j] * r) * A[j];
        if (fout) {
            float* xo = fout + (size_t)row * DM;
#pragma unroll
            for (int j = 0; j < 4; ++j) *(f32x4*)(xo + 4 * lane + 256 * j) = v[j];
        } else {
            bf16_t* xo = XB + (size_t)row * DM; float s2 = 0.f;
#pragma unroll
            for (int j = 0; j < 4; ++j) { u32x2 w; w.x = pk2(v[j][0], v[j][1]); w.y = pk2(v[j][2], v[j][3]); *(u32x2*)(xo + 4 * lane + 256 * j) = w;
                const float a = bf_lo(w.x), b = bf_hi(w.x), c = bf_lo(w.y), d = bf_hi(w.y); s2 += (a * a + b * b) + (c * c + d * d); }
            const float r2 = 1.0f / sqrtf(wave_sum(s2) * (1.0f / DM) + EPS);
            if (lane == 0) rs[row] = r2;
        }
#pragma unroll
        for (int j = 0; j < 4; ++j) { xa[j] = xb[j]; ya[j] = yb[j]; }
    }
}

__device__ __forceinline__ void consts_phase(const Params& p, size_t gt, size_t NGT) {
    unsigned char* ws = p.ws;
    { bf16_t* o = (bf16_t*)(ws + WS_WS); const float* s = p.in[I_AWS]; for (size_t i = gt; i < 2u * 8 * 128 * 128; i += NGT) o[i] = (bf16_t)f2bf(s[i]); }
    { bf16_t* o = (bf16_t*)(ws + WS_G); const float sc = 0.08838834764831845f;
      const float* g2 = p.in[I_NG] + (size_t)2 * 4 * DM;
      for (size_t i = gt; i < 2048u * 256; i += NGT) { const int row = (int)(i >> 8), kk = (int)(i & 255), ri = row >> 10, col = row & 1023, g = col >> 7, l = col & 127;
          float v = 0.f; if ((g & 1) == (kk >> 7)) { const float tr = (float)((l * (kk & 127)) & 127) * (1.0f / 128.0f); v = ri ? -__builtin_amdgcn_sinf(tr) : __builtin_amdgcn_cosf(tr); }
          o[i] = (bf16_t)f2bf(v * sc * g2[256 * (col >> 8) + kk]); } }
    { bf16_t* o1 = (bf16_t*)(ws + WS_T1); bf16_t* o3 = (bf16_t*)(ws + WS_T3); const float sc = 0.08838834764831845f;
      for (size_t i = gt; i < 256u * 256; i += NGT) { const int row = (int)(i >> 8), kk = (int)(i & 255), ro = row >> 7, k1 = row & 127, ri = kk >> 7, s1 = kk & 127;
          const float tr = (float)((k1 * s1) & 127) * (1.0f / 128.0f); const float cv = __builtin_amdgcn_cosf(tr), sv = __builtin_amdgcn_sinf(tr);
          const float t1 = (ro == ri) ? cv : (ro == 0 ? sv : -sv);
          o1[i] = (bf16_t)f2bf(t1 * sc);
          const float t3 = ro ? 0.f : (ri ? sv : cv);
          o3[i] = (bf16_t)f2bf(t3 * sc); } }
    { bf16_t* o = (bf16_t*)(ws + WS_DP); const float sc = 0.022097086912079608f;
      for (size_t i = gt; i < 2048u * 4096; i += NGT) { const int k = (int)(i >> 12), kk = (int)(i & 4095), ri = kk >> 11, s = kk & 2047;
          const float tr = (float)((k * s) & 2047) * (1.0f / 2048.0f); const float v = ri ? __builtin_amdgcn_sinf(tr) : __builtin_amdgcn_cosf(tr);
          o[i] = (bf16_t)f2bf(v * sc); } }
}

__device__ __forceinline__ void qkn_phase(bf16_t* qkv, const float* qn, const float* kn, int gw, int NGW, int lane_, bool dry) {
    int lane = lane_; asm volatile("" : "+v"(lane));
    const int sec = lane >> 5, i = lane & 31, d1 = sec * 64 + i, d2 = d1 + 32;
    const float inv_freq = __builtin_amdgcn_exp2f(-13.287712379549449f * (float)i * (1.0f / 32.0f));
    const float gq1 = qn[d1], gq2 = qn[d2], gk1 = kn[d1], gk2 = kn[d2];
    for (int tok = gw; tok < NTOK; tok += NGW) {
        const int t = tok < NPROMPT ? (tok & (SEQP - 1)) : tok - NPROMPT;
        const float pos = (float)(sec ? (t & 63) : (t >> 6));
        const float ang = pos * inv_freq, cs = __cosf(ang), sn = __sinf(ang);
        bf16_t* row = qkv + (size_t)tok * QKVW;
        unsigned short v1[10], v2[10];
#pragma unroll
        for (int hh = 0; hh < 10; ++hh) { v1[hh] = row[hh * 128 + d1]; v2[hh] = row[hh * 128 + d2]; }
#pragma unroll
        for (int hh = 0; hh < 10; ++hh) {
            const float x1 = __builtin_bit_cast(float, (unsigned)v1[hh] << 16), x2 = __builtin_bit_cast(float, (unsigned)v2[hh] << 16);
            const float r = 1.0f / sqrtf(wave_sum(x1 * x1 + x2 * x2) * (1.0f / 128.0f) + EPS);
            const float y1 = x1 * r * (hh < 8 ? gq1 : gk1), y2 = x2 * r * (hh < 8 ? gq2 : gk2);
            bf16_t o1 = (bf16_t)f2bf(y1 * cs - y2 * sn), o2 = (bf16_t)f2bf(y1 * sn + y2 * cs);
            if (dry && y1 != 12345.678f) { o1 = v1[hh]; o2 = v2[hh]; }
            row[hh * 128 + d1] = o1; row[hh * 128 + d2] = o2;
        }
    }
}

__device__ __forceinline__ void spatial_phase(LAS unsigned char* lds, const bf16_t* wsbf, const bf16_t* VT, bf16_t* U, const float* sumsq, const float* gain, const float* bs,
                                              int G, int bid, bool dry) {
    int tid = threadIdx.x; asm volatile("" : "+v"(tid));
    const int wid = tid >> 6, lane = tid & 63, l15 = lane & 15, lq = lane >> 4;
    constexpr int PITCH = 272;
    LAS float* rvs = (LAS float*)(lds + 128 * PITCH);
    const int pr = tid >> 2, qs = (tid & 3) * 32;
    float sacc = 0.f; u32x4 wraw[4];
    if (bid < 1024) {
        const int c0 = bid >> 3, g0 = bid & 7;
        if (tid < 128) {
#pragma unroll
            for (int k = 0; k < 24; ++k) sacc += sumsq[(size_t)k * NTOK + c0 * 128 + tid];
        }
        const bf16_t* src = wsbf + ((size_t)g0 * 128 + pr) * 128 + qs;
#pragma unroll
        for (int k = 0; k < 4; ++k) wraw[k] = *(const u32x4*)(src + 8 * k);
    }
    for (int item = bid; item < 1024; item += G) {
        const int c = item >> 3, g = item & 7;
        if (tid < 128) rvs[tid] = 1.0f / sqrtf(sacc * (1.0f / AW) + EPS);
        bf16x8 bfr[3][4];
#pragma unroll
        for (int db = 0; db < 3; ++db)
#pragma unroll
            for (int ks = 0; ks < 4; ++ks)
                bfr[db][ks] = *(const bf16x8*)(VT + (size_t)(g * 384 + (3 * wid + db) * 16 + l15) * SLAB + c * 128 + ks * 32 + lq * 8);
        bf16_t* ubase = U + (size_t)(c * 128 + l15) * AW + g * 384 + 3 * wid * 16 + lq * 4;
        u32x2 uv[8][3]; float bsv[8]; f32x4 gn[3];
#pragma unroll
        for (int pb = 0; pb < 8; ++pb) { bsv[pb] = bs[g * 128 + pb * 16 + l15];
#pragma unroll
            for (int db = 0; db < 3; ++db) uv[pb][db] = *(const u32x2*)(ubase + (size_t)(pb * 16) * AW + db * 16); }
#pragma unroll
        for (int db = 0; db < 3; ++db) gn[db] = *(const f32x4*)(gain + g * 384 + (3 * wid + db) * 16 + lq * 4);
        __syncthreads();
        {
#pragma unroll
          for (int k = 0; k < 4; ++k) { const u32x4 w = wraw[k]; u32x4 o;
              const LAS float* rq = rvs + qs + 8 * k;
              o.x = pk2(bf_lo(w.x) * rq[0], bf_hi(w.x) * rq[1]); o.y = pk2(bf_lo(w.y) * rq[2], bf_hi(w.y) * rq[3]);
              o.z = pk2(bf_lo(w.z) * rq[4], bf_hi(w.z) * rq[5]); o.w = pk2(bf_lo(w.w) * rq[6], bf_hi(w.w) * rq[7]);
              *(LAS u32x4*)(lds + pr * PITCH + (qs + 8 * k) * 2) = o; } }
        {
            const int nitem = item + G;
            sacc = 0.f;
            if (nitem < 1024) {
                const int cn = nitem >> 3, gn_ = nitem & 7;
                if (tid < 128) {
#pragma unroll
                    for (int k = 0; k < 24; ++k) sacc += sumsq[(size_t)k * NTOK + cn * 128 + tid];
                }
                const bf16_t* src = wsbf + ((size_t)gn_ * 128 + pr) * 128 + qs;
#pragma unroll
                for (int k = 0; k < 4; ++k) wraw[k] = *(const u32x4*)(src + 8 * k);
            }
        }
        __syncthreads();
#pragma unroll
        for (int pb = 0; pb < 8; ++pb) {
            bf16x8 af[4];
#pragma unroll
            for (int ks = 0; ks < 4; ++ks) af[ks] = *(const LAS bf16x8*)(lds + (pb * 16 + l15) * PITCH + ks * 64 + lq * 16);
            const float bias = bsv[pb];
#pragma unroll
            for (int db = 0; db < 3; ++db) {
                f32x4 a = {0.f, 0.f, 0.f, 0.f};
#pragma unroll
                for (int ks = 0; ks < 4; ++ks) a = __builtin_amdgcn_mfma_f32_16x16x32_bf16(bfr[db][ks], af[ks], a, 0, 0, 0);
                const u32x2 uu = uv[pb][db];
                const f32x4 sv = a * gn[db] + bias;
                u32x2 o; o.x = pk2(bf_lo(uu.x) * sv[0], bf_hi(uu.x) * sv[1]); o.y = pk2(bf_lo(uu.y) * sv[2], bf_hi(uu.y) * sv[3]);
                if (dry && sv[0] != 12345.678f) o = uu;
                *(u32x2*)(ubase + (size_t)(pb * 16) * AW + db * 16) = o;
            }
        }
        __syncthreads();
    }
}

__device__ __forceinline__ void std_desc(pg8::Desc& d, const bf16_t* A, unsigned lda, int M, const bf16_t* B, unsigned ldb, int N, int K, bf16_t* C, unsigned ldc, int mode) {
    d.A = (const char*)A; d.B = (const char*)B; d.lda = lda; d.ldb = ldb; d.ahs = 128u * lda * 2u; d.bhs = 128u * ldb * 2u;
    d.nt = K / 64; d.kmask = 0x3fffffff; d.kshift = 30; d.kpA = 0; d.kpB = 0;
    d.nM = M / 256; d.nN = N / 256; d.nZ = 1; d.a_z = 0; d.a_m = 256u * lda * 2u; d.b_z = 0; d.b_m = 0; d.b_n = 256u * ldb * 2u;
    d.c_z = 0; d.c_m = 256u * ldc; d.c_n = 256; d.C = C; d.ldc = ldc; d.mode = mode; d.aux = nullptr; d.rsc = nullptr; d.csc = nullptr; d.cperm = 0;
}

__global__ void __launch_bounds__(512, 2) mega_fwd(Params p) {
    extern __shared__ __attribute__((aligned(16))) unsigned char lds_raw[];
    LAS unsigned char* lds = (LAS unsigned char*)lds_raw;
    cg::grid_group grid = cg::this_grid();
    const int G = gridDim.x, bid = blockIdx.x, NGW = G * 8;
    unsigned char* ws = p.ws;
    bf16_t* H = (bf16_t*)(ws + WS_H); bf16_t* Y = (bf16_t*)(ws + WS_Y); bf16_t* BIG = (bf16_t*)(ws + WS_BIG);
    bf16_t* WMIX = (bf16_t*)(ws + WS_WMIX); float* sumsq = (float*)(ws + WS_PART); float* RS = (float*)(ws + WS_RS);
    bf16_t* OB = BIG + (size_t)72 * MiB;
    bf16_t* FP = BIG + (size_t)96 * MiB;

    volatile LAS unsigned* bst = (volatile LAS unsigned*)(lds + 131072 + 512);
    if (threadIdx.x < 2) bst[threadIdx.x] = 0u;
    __syncthreads();
    if (bid == 0) {
        unsigned* bw = (unsigned*)(ws + WS_SUMSQ);
        for (int i = threadIdx.x; i < XCD_BAR_WORDS; i += 512) __hip_atomic_store(bw + i, 0u, __ATOMIC_RELAXED, __HIP_MEMORY_SCOPE_AGENT);
        asm volatile("s_waitcnt vmcnt(0)" ::: "memory");
    }
    __syncthreads();
    grid.sync();
    const XcdBarrier xbar = xcd_barrier_post((unsigned*)(ws + WS_SUMSQ), bst);
    for (int st = 0; st < p.nsteps; ++st) {
        const int code = p.steps[st], kind = code & 0xff, L = (code >> 8) & 0xf, s = (code >> 12) & 0xf, do_sync = (code >> 16) & 1; const bool dry = (code >> 17) & 1;
        const int j = L / 3;
        const float* ng = p.in[I_NG] + (size_t)L * 4 * DM;
        bool is_gemm = false; pg8::Desc d;
        int tid = threadIdx.x; asm volatile("" : "+v"(tid));
        const int lane = tid & 63, wave = __builtin_amdgcn_readfirstlane(tid >> 6), gw = bid * 8 + wave;
        LAS float* scr = (LAS float*)(lds + wave * 16384);
        switch (kind) {
        case K_INIT: {
            consts_phase(p, (size_t)bid * 512 + tid, (size_t)G * 512);
            convert_layer(p, 0, scr, gw, NGW, lane);
            rows_phase(p.in[I_XP], p.in[I_XS], H, nullptr, nullptr, RS, nullptr, gw, NGW, lane);
        } break;
        case K_EA: rows_phase(nullptr, nullptr, H, Y, ng + DM, RS, nullptr, gw, NGW, lane); break;
        case K_EB: {
            if (L < 3) {
                convert_layer(p, L + 1, scr, gw, NGW, lane);
                rows_phase(nullptr, nullptr, H, Y, ng + 3 * DM, RS, nullptr, gw, NGW, lane);
            } else rows_phase(nullptr, nullptr, H, Y, ng + 3 * DM, nullptr, p.out, gw, NGW, lane);
        } break;
        case K_QKN: qkn_phase(BIG, p.in[I_BQN] + j * 128, p.in[I_BKN] + j * 128, gw, NGW, lane, dry); break;
#ifndef NO_SG
        case K_SG: spatial_phase(lds, (const bf16_t*)(ws + WS_WS) + (size_t)j * 8 * 128 * 128, BIG + (size_t)SLAB * AW, BIG, sumsq + s * SLAB,
                                 p.in[I_AVN] + j * AW, p.in[I_ABS] + j * 8 * 128, G, bid, dry); break;
#endif
        case K_ATT: {
            for (int U = bid; U < 1536; U += G) {
                int h, qb, tokbase, seq;
                if (U < 512) { h = U & 7; qb = U >> 3; tokbase = NPROMPT; seq = NSAMPLE; }
                else { const int V = U - 512, x = V & 7, v = V >> 3, b = x + 8 * (v >> 6), w = v & 63; h = w >> 3; qb = w & 7; tokbase = b * SEQP; seq = SEQP; }
                const bf16_t* Q = BIG + (size_t)(tokbase + qb * 256) * QKVW + h * 128;
                const bf16_t* Kp = BIG + (size_t)tokbase * QKVW + 1024 + (h >> 2) * 128;
                const bf16_t* Vp = Kp + 256;
                bf16_t* O = OB + (size_t)(tokbase + qb * 256) * DM + h * 128;
#ifndef NO_ATT
                att::attn_dense_body(Q, Kp, Vp, O, seq, (char*)lds_raw);
#endif
                __syncthreads();
            }
        } break;
        case K_GU: is_gemm = true; std_desc(d, H + (size_t)s * SLAB * DM, DM, SLAB, WMIX, DM, AW, DM, BIG, AW, 1); d.rsc = RS + s * SLAB; break;
        case K_GV: is_gemm = true; std_desc(d, WMIX + (size_t)AW * DM, DM, AW, H + (size_t)s * SLAB * DM, DM, SLAB, DM, BIG + (size_t)SLAB * AW, SLAB, 3); d.aux = sumsq + s * SLAB; d.csc = RS + s * SLAB; break;
        case K_GO: is_gemm = true; std_desc(d, BIG, AW, SLAB, (const bf16_t*)(ws + WS_WMIX2_A), AW, DM, AW, Y + (size_t)s * SLAB * DM, DM, 0); break;
        case K_M1: is_gemm = true; std_desc(d, H + (size_t)s * SLAB * DM, DM, SLAB, (const bf16_t*)(ws + WS_WMI), DM, DFF, DM, BIG, DFF, 2); d.rsc = RS + s * SLAB; break;
        case K_M2: is_gemm = true; std_desc(d, BIG, DFF, SLAB, (const bf16_t*)(ws + WS_WMO), DFF, DM, DFF, Y + (size_t)s * SLAB * DM, DM, 0); break;
        case K_QKV: is_gemm = true; std_desc(d, H, DM, NTOK, WMIX, DM, QKVW, DM, BIG, QKVW, 0); d.rsc = RS; break;
        case K_WO: is_gemm = true; std_desc(d, OB, DM, NTOK, (const bf16_t*)(ws + WS_WMIX2_B), DM, DM, DM, Y, DM, 0); break;
        case K_CO: is_gemm = true; std_desc(d, FP, DM, NPROMPT, WMIX, DM, DM, DM, Y, DM, 0); break;
        case K_COS: is_gemm = true; std_desc(d, BIG, DM, NSAMPLE, WMIX, DM, DM, DM, Y + (size_t)NPROMPT * DM, DM, 0); break;
        case K_CDS: {
            is_gemm = true; std_desc(d, (const bf16_t*)(ws + WS_G), 256, 1024, H + (size_t)NPROMPT * DM, 128 * DM, NSAMPLE, 256, BIG, NSAMPLE, 0);
            d.nZ = 2; d.a_z = 1024u * 256 * 2; d.bhs = DM * 2u; d.b_m = 512; d.b_n = 2u * DM * 2; d.c_z = 1024u * NSAMPLE; d.csc = RS + NPROMPT; d.cperm = 1;
        } break;
        case K_CDP: {
            is_gemm = true; std_desc(d, (const bf16_t*)(ws + WS_G), 256, 1024, H, DM, NPROMPT, 256, BIG + (size_t)32 * MiB, NPROMPT, 0);
            d.nZ = 2; d.a_z = 1024u * 256 * 2; d.b_m = 512; d.c_z = 1024u * NPROMPT; d.csc = RS;
        } break;
        case K_F1: {
            is_gemm = true; std_desc(d, (const bf16_t*)(ws + WS_T1), 256, 256, BIG, 128, 131072, 256, Y, 131072, 4);
            d.kmask = 1; d.kshift = 1; d.kpA = 256; d.kpB = 1024u * NSAMPLE * 2;
        } break;
        case K_PD: {
            is_gemm = true; std_desc(d, (const bf16_t*)(ws + WS_DP), 4096, 2048, BIG + (size_t)32 * MiB, NPROMPT, 1024, 4096, FP, DM, 0);
            d.nZ = 16; d.b_z = SEQP * 2u; d.kmask = 31; d.kshift = 5; d.kpA = 4096; d.kpB = 1024u * NPROMPT * 2; d.c_z = (unsigned)SEQP * DM;
        } break;
        case K_F3: {
            is_gemm = true; std_desc(d, (const bf16_t*)(ws + WS_T3), 256, 256, Y, 128, 1024, 256, BIG, 128 * DM, 5);
            d.nZ = 128; d.b_z = 131072u * 2; d.kmask = 1; d.kshift = 1; d.kpA = 256; d.kpB = 128u * 131072 * 2; d.c_z = DM; d.c_m = 0;
        } break;
        default: break;
        }
#ifndef NO_GEMM
        if (is_gemm) { if (dry) d.mode |= 8; pg8::gemm_phase(lds, d, G, bid); }
#endif
#ifdef DBG_DUP_SYNC
        if (do_sync && st != 0) xcd_barrier(xbar);
#endif
        if (do_sync) xcd_barrier(xbar);
    }
}

static inline int enc(int kind, int layer, int slab, int sync) { return kind | (layer << 8) | (slab << 12) | (sync << 16); }
extern "C" void kernel_launch(void* const* d_in, const int* in_sizes, int n_in, void* d_out, int out_size, void* d_ws, size_t ws_size, hipStream_t stream) {
    static int grid = 0;
    if (grid == 0) {
        if (n_in != 15 || ws_size < WS_END) { fprintf(stderr, "kernel_launch: unexpected n_in %d / ws_size %zu\n", n_in, ws_size); grid = -1; return; }
        int dev = 0, cus = 0, per_cu = 0;
        hipGetDevice(&dev); hipDeviceGetAttribute(&cus, hipDeviceAttributeMultiprocessorCount, dev);
        if (hipFuncSetAttribute((const void*)mega_fwd, hipFuncAttributeMaxDynamicSharedMemorySize, LDS_BYTES) != hipSuccess) { fprintf(stderr, "hipFuncSetAttribute failed\n"); grid = -1; return; }
        if (hipOccupancyMaxActiveBlocksPerMultiprocessor(&per_cu, (const void*)mega_fwd, 512, LDS_BYTES) != hipSuccess || per_cu < 1) { fprintf(stderr, "occupancy query: %d\n", per_cu); per_cu = 1; }
        (void)hipGetLastError();
        grid = cus * 1;
        fprintf(stderr, "kernel_launch: grid %d (per_cu %d) ws %zu\n", grid, per_cu, ws_size);
    }
    if (grid < 0) return;
    Params p{};
    for (int i = 0; i < 15; ++i) p.in[i] = (const float*)d_in[i];
    p.out = (float*)d_out; p.ws = (unsigned char*)d_ws;
    int n = 0;
    p.steps[n++] = enc(K_INIT, 0, 0, 1);
#ifdef DBG_DUP_INIT
    p.steps[n++] = enc(K_INIT, 0, 0, 1);
#endif
    for (int L = 0; L < 4; ++L) {
        const int m = L % 3;
        if (m == 0) {
            for (int s = 0; s < 3; ++s) { p.steps[n++] = enc(K_GU, L, s, 0); p.steps[n++] = enc(K_GV, L, s, 1);
#ifdef DBG_DUP_GMLP
                p.steps[n++] = enc(K_GU, L, s, 0); p.steps[n++] = enc(K_GV, L, s, 1);
#endif

#ifdef DBG_DUP_SG
                p.steps[n++] = enc(K_SG, L, s, 1) | (1 << 17);
#endif
                p.steps[n++] = enc(K_SG, L, s, 1); p.steps[n++] = enc(K_GO, L, s, 1);
#ifdef DBG_DUP_GMLP
                p.steps[n++] = enc(K_GO, L, s, 1);
#endif
            }
        } else if (m == 1) {
            p.steps[n++] = enc(K_QKV, L, 0, 1);
#ifdef DBG_DUP_MISC
            p.steps[n++] = enc(K_QKV, L, 0, 1);
#endif

#ifdef DBG_DUP_QKN
            p.steps[n++] = enc(K_QKN, L, 0, 1) | (1 << 17);
#endif
            p.steps[n++] = enc(K_QKN, L, 0, 1); p.steps[n++] = enc(K_ATT, L, 0, 1);
#ifdef DBG_DUP_ATT
            p.steps[n++] = enc(K_ATT, L, 0, 1);
#endif
 p.steps[n++] = enc(K_WO, L, 0, 1);
#ifdef DBG_DUP_MISC
            p.steps[n++] = enc(K_WO, L, 0, 1);
#endif
        } else {
#if defined(DBG_SKIP_S)
            p.steps[n++] = enc(K_CDP, L, 0, 1); p.steps[n++] = enc(K_PD, L, 0, 1); p.steps[n++] = enc(K_CO, L, 0, 0); p.steps[n++] = enc(K_COS, L, 0, 1);
#elif defined(DBG_SKIP_P)
            p.steps[n++] = enc(K_CDS, L, 0, 1); p.steps[n++] = enc(K_F1, L, 0, 1); p.steps[n++] = enc(K_F3, L, 0, 1); p.steps[n++] = enc(K_CO, L, 0, 0); p.steps[n++] = enc(K_COS, L, 0, 1);
#else
            p.steps[n++] = enc(K_CDS, L, 0, 0); p.steps[n++] = enc(K_CDP, L, 0, 1); p.steps[n++] = enc(K_F1, L, 0, 0); p.steps[n++] = enc(K_PD, L, 0, 1);
            p.steps[n++] = enc(K_F3, L, 0, 1); p.steps[n++] = enc(K_CO, L, 0, 0); p.steps[n++] = enc(K_COS, L, 0, 1);
#ifdef DBG_DUP_MISC
            p.steps[n++] = enc(K_CO, L, 0, 0); p.steps[n++] = enc(K_COS, L, 0, 1);
#endif
#ifdef DBG_DUP_FFT
            p.steps[n++] = enc(K_CDS, L, 0, 0); p.steps[n++] = enc(K_CDP, L, 0, 1); p.steps[n++] = enc(K_F1, L, 0, 0); p.steps[n++] = enc(K_PD, L, 0, 1);
            p.steps[n++] = enc(K_F3, L, 0, 1); p.steps[n++] = enc(K_CO, L, 0, 0); p.steps[n++] = enc(K_COS, L, 0, 1);
#endif
#endif
        }
        p.steps[n++] = enc(K_EA, L, 0, 1);
        for (int s = 0; s < 3; ++s) { p.steps[n++] = enc(K_M1, L, s, 1);
#ifdef DBG_DUP_MLP
            p.steps[n++] = enc(K_M1, L, s, 1) | (DBG_DUP_MLP << 17); p.steps[n++] = enc(K_M2, L, s, 1) | (DBG_DUP_MLP << 17);
#endif
            p.steps[n++] = enc(K_M2, L, s, 1); }
        p.steps[n++] = enc(K_EB, L, 0, L < 3 ? 1 : 0);
    }
#ifdef DBG_STEPS
    if (n > DBG_STEPS) n = DBG_STEPS;
#endif
    p.nsteps = n;
    void* args[] = {&p};
    hipError_t e = hipLaunchCooperativeKernel((const void*)mega_fwd, dim3(grid), dim3(512), args, LDS_BYTES, stream);
    if (e != hipSuccess) fprintf(stderr, "cooperative launch failed: %s (grid %d)\n", hipGetErrorString(e), grid);
}
```
